# Optimizing an MI355X kernel written in HIP

```python
import jax, jax.numpy as jnp
from jax import lax
import numpy as np

D_MODEL = 1024
BATCH = 4
SEQ = 8192
DEPTH = 1
DEC_BATCH = 128
DEC_SEQ = 4
PAST_LEN = 16384
PAGE_SIZE = 128

N_HEADS = 8
N_KV_HEADS = 2
HEAD_DIM = 64
GROUP = N_HEADS // N_KV_HEADS
ATTN_W = N_HEADS * HEAD_DIM
KV_W = N_KV_HEADS * HEAD_DIM
WINDOW = 128
LRU_W = D_MODEL // 2
LRU_BLOCKS = 8
LRU_BW = LRU_W // LRU_BLOCKS
CONV_W = 4
LRU_C = 8.0
MIX_W = ATTN_W + LRU_W
IN_W = ATTN_W + 2 * KV_W + 2 * LRU_W
Q_END = ATTN_W
K_END = Q_END + KV_W
V_END = K_END + KV_W
X_END = V_END + LRU_W
D_FF = -(-8 * D_MODEL // (3 * 256)) * 256
EPS = 1e-6
NEG = -1e30

kernel_name = "hymba_swa_sink_rglru_decoder_step"


def _rmsnorm(x, g):
    xf = x.astype(jnp.float32)
    y = xf * lax.rsqrt(jnp.mean(xf * xf, axis=-1, keepdims=True) + EPS) * g.astype(jnp.float32)
    return y.astype(x.dtype)


def _alibi_slopes():
    return jnp.exp2(-8.0 * jnp.arange(1, N_HEADS + 1, dtype=jnp.float32) / N_HEADS)


def _sink_attend(q, kb, vb, dist, sinks):
    s = jnp.einsum('bnqkgd,bnskd->bnkgqs', q, kb).astype(jnp.float32) * (HEAD_DIM ** -0.5)
    slopes = _alibi_slopes().reshape(N_KV_HEADS, GROUP, 1, 1)
    valid = ((dist >= 0) & (dist < WINDOW))[None, :, None, None]
    distf = dist.astype(jnp.float32)[None, :, None, None]
    s = jnp.where(valid, s - slopes * distf, NEG)
    sink = sinks.astype(jnp.float32).reshape(N_KV_HEADS, GROUP, 1, 1)
    m = jnp.maximum(jnp.max(s, axis=-1, keepdims=True), sink)
    p = jnp.exp(s - m)
    p = p / (jnp.sum(p, axis=-1, keepdims=True) + jnp.exp(sink - m))
    out = jnp.einsum('bnkgqs,bnskd->bnqkgd', p.astype(vb.dtype), vb)
    B, n, Tq = out.shape[:3]
    return out.reshape(B, n * Tq, ATTN_W)


def _attn_prompt(q, k, v, sinks):
    B, T = q.shape[:2]
    nb = T // WINDOW
    qb = q.reshape(B, nb, WINDOW, N_KV_HEADS, GROUP, HEAD_DIM)

    def band(t):
        tb = t.reshape(B, nb, WINDOW, N_KV_HEADS, HEAD_DIM)
        prev = jnp.pad(tb[:, :-1], ((0, 0), (1, 0), (0, 0), (0, 0), (0, 0)))
        return jnp.concatenate([prev, tb], axis=2)

    i = jnp.arange(WINDOW)[:, None]
    j = jnp.arange(2 * WINDOW)[None, :]
    d = WINDOW + i - j
    first = (jnp.arange(nb)[:, None, None] == 0) & (j[None] < WINDOW)
    dist = jnp.where(first, -1, d[None])
    out = _sink_attend(qb, band(k), band(v), dist, sinks)
    return out, k[:, -WINDOW:], v[:, -WINDOW:]


def _attn_sample(q, k, v, ck, cv, sinks):
    T = q.shape[1]
    kall = jnp.concatenate([ck.astype(k.dtype), k], axis=1)
    vall = jnp.concatenate([cv.astype(v.dtype), v], axis=1)
    i = jnp.arange(T)[:, None]
    j = jnp.arange(WINDOW + T)[None, :]
    dist = (WINDOW + i - j)[None]
    out = _sink_attend(q[:, None], kall[:, None], vall[:, None], dist, sinks)
    return out, kall[:, -WINDOW:], vall[:, -WINDOW:]


def _causal_conv(x, prefix, w, b):
    T = x.shape[1]
    xp = jnp.concatenate([prefix.astype(x.dtype), x], axis=1)
    out = b + w[0] * xp[:, 0:T]
    for kk in range(1, CONV_W):
        out = out + w[kk] * xp[:, kk:kk + T]
    return out, xp[:, T:]


def _block_diag(x, w, b):
    B, T = x.shape[:2]
    xr = x.reshape(B, T, LRU_BLOCKS, LRU_BW)
    return jnp.einsum('btnd,nde->btne', xr, w).reshape(B, T, LRU_W) + b


def _rg_lru(x, h0, w_a, b_a, w_i, b_i, lam):
    xf = x.astype(jnp.float32)
    r = jax.nn.sigmoid(_block_diag(x, w_a, b_a).astype(jnp.float32))
    ig = jax.nn.sigmoid(_block_diag(x, w_i, b_i).astype(jnp.float32))
    log_a = -LRU_C * r * jax.nn.softplus(-lam.astype(jnp.float32))
    a = jnp.exp(log_a)
    bterm = jnp.sqrt(-jnp.expm1(2.0 * log_a)) * (ig * xf)

    def step(h, ab):
        a_t, b_t = ab
        h = a_t * h + b_t
        return h, h

    h_last, hs = lax.scan(step, h0.astype(jnp.float32), (jnp.swapaxes(a, 0, 1), jnp.swapaxes(bterm, 0, 1)))
    return jnp.swapaxes(hs, 0, 1).astype(x.dtype), h_last


def _layer(x, mode, ck, cv, conv_prefix, h0, g_mix, w_in, b_in, attn_sinks, conv_w, conv_b,
           w_a, b_a, w_i, b_i, lam, w_out, b_out, g_ffn, w_ffn_in, w_ffn_out):
    B, T, _ = x.shape
    u = _rmsnorm(x, g_mix)
    z = u @ w_in + b_in
    q, k, v, xb, yb = jnp.split(z, [Q_END, K_END, V_END, X_END], axis=-1)
    q = q.reshape(B, T, N_KV_HEADS, GROUP, HEAD_DIM)
    k = k.reshape(B, T, N_KV_HEADS, HEAD_DIM)
    v = v.reshape(B, T, N_KV_HEADS, HEAD_DIM)
    if mode == 'prompt':
        attn, nk, nv = _attn_prompt(q, k, v, attn_sinks)
    else:
        attn, nk, nv = _attn_sample(q, k, v, ck, cv, attn_sinks)
    xc, nconv = _causal_conv(xb, conv_prefix, conv_w, conv_b)
    lru, nh = _rg_lru(xc, h0, w_a, b_a, w_i, b_i, lam)
    mix = jnp.concatenate([attn, lru * jax.nn.gelu(yb)], axis=-1)
    h = x + mix @ w_out + b_out
    gate, up = jnp.split(_rmsnorm(h, g_ffn) @ w_ffn_in, [D_FF], axis=-1)
    y = h + (jax.nn.silu(gate) * up) @ w_ffn_out
    return y, nk, nv, nconv, nh


def setup_inputs(seed: int = 0) -> dict:
    key = jax.random.key(seed)
    ks = jax.random.split(key, 23)

    def nrm(k, shape, scale):
        return jax.random.normal(k, shape, jnp.float32) * scale

    u = jax.random.uniform(ks[16], (DEPTH, LRU_W), jnp.float32, minval=0.9, maxval=0.999)
    return {
        'x_prompt': nrm(ks[0], (BATCH, SEQ, D_MODEL), 1.0),
        'x_sample': nrm(ks[1], (DEC_BATCH, DEC_SEQ, D_MODEL), 1.0),
        'cache_k': nrm(ks[2], (DEPTH, DEC_BATCH, WINDOW, N_KV_HEADS, HEAD_DIM), 1.0),
        'cache_v': nrm(ks[3], (DEPTH, DEC_BATCH, WINDOW, N_KV_HEADS, HEAD_DIM), 1.0),
        'state_conv': nrm(ks[4], (DEPTH, DEC_BATCH, CONV_W - 1, LRU_W), 1.0),
        'state_h': nrm(ks[5], (DEPTH, DEC_BATCH, LRU_W), 0.5),
        'g_mix': 1.0 + nrm(ks[6], (DEPTH, D_MODEL), 0.02),
        'w_in': nrm(ks[7], (DEPTH, D_MODEL, IN_W), D_MODEL ** -0.5),
        'b_in': nrm(ks[8], (DEPTH, IN_W), 0.02),
        'attn_sinks': nrm(ks[9], (DEPTH, N_HEADS), 0.5),
        'conv_w': nrm(ks[10], (DEPTH, CONV_W, LRU_W), CONV_W ** -0.5),
        'conv_b': nrm(ks[11], (DEPTH, LRU_W), 0.02),
        'w_a': nrm(ks[12], (DEPTH, LRU_BLOCKS, LRU_BW, LRU_BW), LRU_BW ** -0.5),
        'b_a': nrm(ks[13], (DEPTH, LRU_W), 0.02),
        'w_i': nrm(ks[14], (DEPTH, LRU_BLOCKS, LRU_BW, LRU_BW), LRU_BW ** -0.5),
        'b_i': nrm(ks[15], (DEPTH, LRU_W), 0.02),
        'lam': jnp.log(u) - jnp.log1p(-u),
        'w_out': nrm(ks[17], (DEPTH, MIX_W, D_MODEL), MIX_W ** -0.5),
        'b_out': nrm(ks[18], (DEPTH, D_MODEL), 0.02),
        'g_ffn': 1.0 + nrm(ks[19], (DEPTH, D_MODEL), 0.02),
        'w_ffn_in': nrm(ks[20], (DEPTH, D_MODEL, 2 * D_FF), D_MODEL ** -0.5),
        'w_ffn_out': nrm(ks[21], (DEPTH, D_FF, D_MODEL), D_FF ** -0.5),
        'g_final': 1.0 + nrm(ks[22], (D_MODEL,), 0.02),
    }


def reference(x_prompt, x_sample, cache_k, cache_v, state_conv, state_h, g_mix, w_in, b_in,
              attn_sinks, conv_w, conv_b, w_a, b_a, w_i, b_i, lam, w_out, b_out, g_ffn,
              w_ffn_in, w_ffn_out, g_final):
    yp, ys = x_prompt, x_sample
    pk, pv, pc, ph, sk, sv, sc, sh = [], [], [], [], [], [], [], []
    conv0 = jnp.zeros((x_prompt.shape[0], CONV_W - 1, LRU_W), x_prompt.dtype)
    h_zero = jnp.zeros((x_prompt.shape[0], LRU_W), jnp.float32)
    for l in range(DEPTH):
        lp = (g_mix[l], w_in[l], b_in[l], attn_sinks[l], conv_w[l], conv_b[l], w_a[l], b_a[l],
              w_i[l], b_i[l], lam[l], w_out[l], b_out[l], g_ffn[l], w_ffn_in[l], w_ffn_out[l])
        yp, k1, v1, c1, h1 = _layer(yp, 'prompt', None, None, conv0, h_zero, *lp)
        ys, k2, v2, c2, h2 = _layer(ys, 'sample', cache_k[l], cache_v[l], state_conv[l], state_h[l], *lp)
        pk.append(k1); pv.append(v1); pc.append(c1); ph.append(h1)
        sk.append(k2); sv.append(v2); sc.append(c2); sh.append(h2)
    y_prompt = _rmsnorm(yp, g_final)
    y_sample = _rmsnorm(ys, g_final)
    return (y_prompt, y_sample,
            jnp.stack(pk), jnp.stack(pv), jnp.stack(pc), jnp.stack(ph),
            jnp.stack(sk), jnp.stack(sv), jnp.stack(sc), jnp.stack(sh))
```

```cpp
#include <hip/hip_runtime.h>
#include <hip/hip_cooperative_groups.h>
#include <cstdio>
#include <cstdint>
namespace cg = cooperative_groups;
namespace pg8 {
#define PG8_LAS __attribute__((address_space(3)))
typedef unsigned short bf16_t;
typedef short bf16x8 __attribute__((ext_vector_type(8)));
typedef float f32x4 __attribute__((ext_vector_type(4)));
typedef unsigned u32x4 __attribute__((ext_vector_type(4)));
constexpr int BM = 256, BK = 64, HALF = 128, HTB = HALF * BK * 2  , STAGE_BYTES = 8 * HTB, NXCD = 8, WGM = 8;

__host__ __device__ __forceinline__ int lds_byte(int r, int c) { const int st = (r >> 4) * 2 + (c >> 5), rr = r & 15, cc = c & 31, ob = rr * 64 + cc * 2; return st * 1024 + (ob ^ (((ob >> 9) & 1) << 5)); }
__host__ __device__ __forceinline__ void stage_rc(int b, int& R, int& C) { const int st = b / 1024, sb = b % 1024, swz = sb ^ (((sb >> 9) & 1) << 5); R = (st >> 1) * 16 + swz / 64; C = (st & 1) * 32 + (swz % 64) / 2; }
__host__ __device__ __forceinline__ int perm32(int rho) { const int n = rho >> 4, i = rho & 15; return 8 * (i >> 2) + 4 * n + (i & 3); }

struct Unit { int pm, pn; };
struct Gemm { const bf16_t* A; const bf16_t* Bt; int M, N, K; };

struct StaticOrder {
    int nM, nN, nwg, G, c;
    __host__ __device__ void init(int M, int N, int G_, int c_) { nM = M / BM; nN = N / BM; nwg = nM * nN; G = G_; c = c_; }
    __host__ __device__ bool next(int i, Unit& u) const {
        const long L = (long)i * G + c; if (L >= nwg) return false;
        int wgid = (int)L; { const int q = nwg / NXCD, r = nwg % NXCD, xcd = wgid % NXCD, off = wgid / NXCD; wgid = (xcd < r ? xcd * (q + 1) : r * (q + 1) + (xcd - r) * q) + off; }
        const int nig = WGM * nN, gid = wgid / nig, fm = gid * WGM, gsz = (nM - fm) < WGM ? (nM - fm) : WGM;
        u.pm = fm + ((wgid % nig) % gsz); u.pn = (wgid % nig) / gsz; return true;
    }
    __device__ __forceinline__ void a_ready(const Unit&) const {}
    __device__ __forceinline__ void done(const Unit&) const {}
};
__device__ __forceinline__ unsigned cvt_pk_bf16(float lo, float hi) { unsigned r; asm volatile("v_cvt_pk_bf16_f32 %0, %1, %2" : "=v"(r) : "v"(lo), "v"(hi)); return r; }
template <class Epi, class Sched, bool ALIGN_EPI = false, bool SP2 = false>
__device__ __forceinline__ void gemm_phase(PG8_LAS unsigned char* lds, const Gemm g, const Sched& S, const Epi& E) {
    const int tid = threadIdx.x, wid = __builtin_amdgcn_readfirstlane(tid >> 6), lane = tid & 63, wr = wid >> 2, wc = wid & 3, fr = lane & 15, fq = lane >> 4;
    const int K = g.K, nt = K / BK;
    unsigned voffA[2], voffB[2];
#pragma unroll
    for (int i = 0; i < 2; ++i) { int R, C; stage_rc(tid * 16 + i * 8192, R, C); const int Rb = Epi::PERM ? ((R & ~31) + perm32(R & 31)) : R;
        voffA[i] = (unsigned)(R * K + C) * 2u; voffB[i] = (unsigned)(Rb * K + C) * 2u; }
    const size_t kstep = (size_t)(BK * 2);
    const size_t hstep = (size_t)HALF * K * 2;
    const size_t tstep = 2 * hstep;
    const unsigned ldsw = (unsigned)wid * 1024u;
    const int aoff = lds_byte(wr * 64 + fr, fq * 8), boff = lds_byte(wc * 32 + fr, fq * 8);
#define PG8_SA(b, h) (((b) * 2 + (h)) * HTB)
#define PG8_SB(b, h) ((4 + (b) * 2 + (h)) * HTB)
#define PG8_STAGE(bufoff, gbase, voff) do { _Pragma("unroll") for (int _i = 0; _i < 2; ++_i) \
        __builtin_amdgcn_global_load_lds((const unsigned*)((const char*)(gbase) + (voff)[_i]), (PG8_LAS unsigned*)(lds + (bufoff) + ldsw + _i * 8192), 16, 0, 0); } while (0)
#define PG8_LDA(dst, b, h) do { _Pragma("unroll") for (int m = 0; m < 4; ++m) _Pragma("unroll") for (int k = 0; k < 2; ++k) dst[m][k] = *(const PG8_LAS bf16x8*)(lds + PG8_SA(b, h) + aoff + m * 2048 + k * 1024); } while (0)
#define PG8_LDB(dst, b, h) do { _Pragma("unroll") for (int n = 0; n < 2; ++n) _Pragma("unroll") for (int k = 0; k < 2; ++k) dst[n][k] = *(const PG8_LAS bf16x8*)(lds + PG8_SB(b, h) + boff + n * 2048 + k * 1024); } while (0)
#define PG8_MMA(ai, bj, At, Bt) do { __builtin_amdgcn_s_setprio(1); _Pragma("unroll") for (int m = 0; m < 4; ++m) _Pragma("unroll") for (int n = 0; n < 2; ++n) _Pragma("unroll") for (int k = 0; k < 2; ++k) \
        acc[ai][bj][m][n] = __builtin_amdgcn_mfma_f32_16x16x32_bf16(Bt[n][k], At[m][k], acc[ai][bj][m][n], 0, 0, 0); __builtin_amdgcn_s_setprio(0); } while (0)
#define PG8_WAIT_V(n) asm volatile("s_waitcnt vmcnt(" #n ")" ::: "memory")
#define PG8_WAIT_L(n) asm volatile("s_waitcnt lgkmcnt(" #n ")" ::: "memory")
#define PG8_BAR __builtin_amdgcn_s_barrier()
#define PG8_SCHED __builtin_amdgcn_sched_barrier(0)
    Unit cur, nxt; int ui = 0;
    if (!S.next(0, cur)) return;
    f32x4 acc[2][2][4][2];
#pragma unroll
    for (int a = 0; a < 2; ++a)
#pragma unroll
        for (int b = 0; b < 2; ++b)
#pragma unroll
            for (int m = 0; m < 4; ++m)
#pragma unroll
                for (int n = 0; n < 2; ++n) acc[a][b][m][n] = (f32x4){0.f, 0.f, 0.f, 0.f};
    bf16x8 At[4][2], B0[2][2], B1[2][2];
    const char* cA = (const char*)g.A + (size_t)cur.pm * tstep; const char* cB = (const char*)g.Bt + (size_t)cur.pn * tstep;
    S.a_ready(cur);
    if constexpr (SP2) {
        PG8_STAGE(PG8_SB(0, 0), cB, voffB); PG8_STAGE(PG8_SB(0, 1), cB + hstep, voffB); PG8_STAGE(PG8_SA(0, 0), cA, voffA); PG8_STAGE(PG8_SA(0, 1), cA + hstep, voffA);
        if (wr == 1) PG8_BAR;
        PG8_WAIT_V(2); PG8_BAR;
        PG8_STAGE(PG8_SB(1, 0), cB + kstep, voffB); PG8_STAGE(PG8_SA(1, 0), cA + kstep, voffA); PG8_STAGE(PG8_SB(1, 1), cB + hstep + kstep, voffB);
        PG8_WAIT_V(6); PG8_BAR;
    } else {
        PG8_STAGE(PG8_SB(0, 0), cB, voffB); PG8_STAGE(PG8_SA(0, 0), cA, voffA); PG8_STAGE(PG8_SB(0, 1), cB + hstep, voffB); PG8_STAGE(PG8_SA(0, 1), cA + hstep, voffA);
        if (wr == 1) PG8_BAR;
        PG8_WAIT_V(4); PG8_BAR;
        PG8_STAGE(PG8_SB(1, 0), cB + kstep, voffB); PG8_STAGE(PG8_SA(1, 0), cA + kstep, voffA); PG8_STAGE(PG8_SB(1, 1), cB + hstep + kstep, voffB);
        PG8_WAIT_V(6); PG8_BAR;
    }
    for (;;) {
        const bool has_next = S.next(ui + 1, nxt);
        const char* nA = has_next ? (const char*)g.A + (size_t)nxt.pm * tstep : cA; const char* nB = has_next ? (const char*)g.Bt + (size_t)nxt.pn * tstep : cB;
        for (int t = 0; t < nt; t += 2) {
            const bool last = (t == nt - 2);
            const char* a1 = cA + (size_t)(t + 1) * kstep;
            const char* a2 = last ? nA : cA + (size_t)(t + 2) * kstep; const char* b2 = last ? nB : cB + (size_t)(t + 2) * kstep;
            const char* a3 = a2 + kstep; const char* b3 = b2 + kstep;
            if (last && has_next) S.a_ready(nxt);
            if constexpr (SP2) {
            PG8_LDB(B0, 0, 0); PG8_LDB(B1, 0, 1); PG8_SCHED; PG8_LDA(At, 0, 0); PG8_STAGE(PG8_SA(1, 1), a1 + hstep, voffA);
            PG8_WAIT_V(8); PG8_WAIT_L(0); PG8_BAR; PG8_MMA(0, 0, At, B0); PG8_MMA(0, 1, At, B1); PG8_BAR; PG8_SCHED;
            PG8_LDA(At, 0, 1); PG8_STAGE(PG8_SB(0, 0), b2, voffB); PG8_STAGE(PG8_SB(0, 1), b2 + hstep, voffB); PG8_STAGE(PG8_SA(0, 0), a2, voffA);
            PG8_WAIT_V(8); PG8_WAIT_L(0); PG8_BAR; PG8_MMA(1, 0, At, B0); PG8_MMA(1, 1, At, B1); PG8_BAR; PG8_SCHED;
            PG8_LDB(B0, 1, 0); PG8_LDB(B1, 1, 1); PG8_SCHED; PG8_LDA(At, 1, 0); PG8_STAGE(PG8_SA(0, 1), a2 + hstep, voffA);
            PG8_WAIT_V(8); PG8_WAIT_L(0); PG8_BAR; PG8_MMA(0, 0, At, B0); PG8_MMA(0, 1, At, B1); PG8_BAR; PG8_SCHED;
            PG8_LDA(At, 1, 1); PG8_STAGE(PG8_SB(1, 0), b3, voffB); PG8_STAGE(PG8_SB(1, 1), b3 + hstep, voffB); PG8_STAGE(PG8_SA(1, 0), a3, voffA);
            PG8_WAIT_V(8); PG8_WAIT_L(0); PG8_BAR; PG8_MMA(1, 0, At, B0); PG8_MMA(1, 1, At, B1); PG8_BAR; PG8_SCHED;
            } else {
            PG8_LDB(B0, 0, 0); PG8_SCHED; PG8_LDA(At, 0, 0); PG8_STAGE(PG8_SA(1, 1), a1 + hstep, voffA);
            PG8_WAIT_L(8); PG8_BAR; PG8_WAIT_L(0); PG8_MMA(0, 0, At, B0); PG8_BAR; PG8_SCHED;
            PG8_LDB(B1, 0, 1); PG8_STAGE(PG8_SB(0, 0), b2, voffB);
            PG8_BAR; PG8_WAIT_L(0); PG8_MMA(0, 1, At, B1); PG8_BAR;
            PG8_LDA(At, 0, 1); PG8_STAGE(PG8_SA(0, 0), a2, voffA);
            PG8_BAR; PG8_WAIT_L(0); PG8_MMA(1, 0, At, B0); PG8_BAR; PG8_SCHED;
            PG8_STAGE(PG8_SB(0, 1), b2 + hstep, voffB);
            PG8_WAIT_V(6); PG8_BAR; PG8_MMA(1, 1, At, B1); PG8_BAR;
            PG8_LDB(B0, 1, 0); PG8_SCHED; PG8_LDA(At, 1, 0); PG8_STAGE(PG8_SA(0, 1), a2 + hstep, voffA);
            PG8_WAIT_L(8); PG8_BAR; PG8_WAIT_L(0); PG8_MMA(0, 0, At, B0); PG8_BAR; PG8_SCHED;
            PG8_LDB(B1, 1, 1); PG8_STAGE(PG8_SB(1, 0), b3, voffB);
            PG8_BAR; PG8_WAIT_L(0); PG8_MMA(0, 1, At, B1); PG8_BAR;
            PG8_LDA(At, 1, 1); PG8_STAGE(PG8_SA(1, 0), a3, voffA);
            PG8_BAR; PG8_WAIT_L(0); PG8_MMA(1, 0, At, B0); PG8_BAR; PG8_SCHED;
            PG8_STAGE(PG8_SB(1, 1), b3 + hstep, voffB);
            PG8_WAIT_V(6); PG8_BAR; PG8_MMA(1, 1, At, B1); PG8_BAR;
            }
        }
        if constexpr (ALIGN_EPI) { if (wr == 0) PG8_BAR; }
        if constexpr (!Epi::AFTER_DRAIN) { E(acc, cur, wr, wc, fr, fq); S.done(cur); }
        if (!has_next) break;
#pragma unroll
        for (int a = 0; a < 2; ++a)
#pragma unroll
            for (int b = 0; b < 2; ++b)
#pragma unroll
                for (int m = 0; m < 4; ++m)
#pragma unroll
                    for (int n = 0; n < 2; ++n) acc[a][b][m][n] = (f32x4){0.f, 0.f, 0.f, 0.f};
        cur = nxt; cA = nA; cB = nB; ++ui;
        if constexpr (ALIGN_EPI) { if (wr == 1) PG8_BAR; }
    }
    PG8_WAIT_V(0);
    if constexpr (!ALIGN_EPI) { if (wr == 0) PG8_BAR; }
    PG8_BAR;
    if constexpr (Epi::AFTER_DRAIN) { E.fused(acc, cur, wr, wc, fr, fq, lds, wid, lane); S.done(cur); }
#undef PG8_SA
#undef PG8_SB
#undef PG8_STAGE
#undef PG8_LDA
#undef PG8_LDB
#undef PG8_MMA
#undef PG8_WAIT_V
#undef PG8_WAIT_L
#undef PG8_BAR
#undef PG8_SCHED
}
}

#define LAS __attribute__((address_space(3)))
typedef unsigned short bf16;
typedef short bf16x8 __attribute__((ext_vector_type(8)));
typedef short s16x4 __attribute__((ext_vector_type(4)));
typedef float f32x4 __attribute__((ext_vector_type(4)));
typedef float f32x16 __attribute__((ext_vector_type(16)));
typedef unsigned u32x4 __attribute__((ext_vector_type(4)));
typedef unsigned u32x2 __attribute__((ext_vector_type(2)));

constexpr int D_MODEL = 1024, NPROMPT = 32768, NSAMPLE = 512, MROWS = NPROMPT + NSAMPLE;
constexpr int SEQ = 8192, IN_W = 1792, D_FF = 2816;
constexpr float EPS = 1e-6f, LOG2E = 1.4426950408889634f, QSCALE = 0.125f * LOG2E;
constexpr size_t O_YP = 0, O_YS = 33554432, O_KP = 34078720, O_VP = 34144256, O_CP = 34209792, O_HP = 34215936, O_KS = 34217984, O_VS = 36315136, O_CS = 38412288, O_HS = 38608896;
constexpr size_t MiB = 1u << 20;
constexpr size_t WS_WIN = 1 * MiB, WS_WOUT = 5 * MiB, WS_WFI = 7 * MiB, WS_WFO = 18 * MiB, WS_WA = 24 * MiB, WS_WI = 24 * MiB + 65536;
constexpr size_t WS_SUMA = 25 * MiB, WS_SUMB = 26 * MiB, WS_SS2 = 27 * MiB, WS_SS3 = 30 * MiB, WS_HB = 33 * MiB;
constexpr size_t WS_XN = 98 * MiB, WS_Q = 163 * MiB, WS_K = 196 * MiB, WS_V = 205 * MiB, WS_XB = 214 * MiB, WS_GY = 247 * MiB, WS_MIX = 280 * MiB, WS_ACT = 98 * MiB, WS_END = 345 * MiB;
constexpr int LDS_BYTES = 147456;

struct Params { const float* in[23]; float* out; unsigned char* ws; int ph_lo, ph_hi; };

__device__ __forceinline__ unsigned pk2(float lo, float hi) {
    typedef __bf16 bf2 __attribute__((ext_vector_type(2)));
    bf2 v; v.x = (__bf16)lo; v.y = (__bf16)hi; return __builtin_bit_cast(unsigned, v);
}
__device__ __forceinline__ unsigned short f2bf(float f) { return (unsigned short)(pk2(f, 0.f) & 0xffffu); }
__device__ __forceinline__ float bf2f(unsigned short b) { return __uint_as_float((unsigned)b << 16); }
__device__ __forceinline__ void store8(bf16* dst, f32x4 a, f32x4 b) {
    u32x4 w; w.x = pk2(a[0], a[1]); w.y = pk2(a[2], a[3]); w.z = pk2(b[0], b[1]); w.w = pk2(b[2], b[3]); *(u32x4*)dst = w;
}
__device__ __forceinline__ float fast_sigmoid(float x) { return __builtin_amdgcn_rcpf(1.0f + __expf(-x)); }
__device__ __forceinline__ float gelu_tanh(float x) { const float u = 0.7978845608028654f * (x + 0.044715f * x * x * x); return x * __builtin_amdgcn_rcpf(1.0f + __expf(-2.0f * u)); }
__device__ __forceinline__ float wave_sum(float v) {
#pragma unroll
    for (int o = 1; o < 64; o <<= 1) v += __shfl_xor(v, o);
    return v;
}
__device__ __forceinline__ float wave_max(float v) {
#pragma unroll
    for (int o = 1; o < 64; o <<= 1) v = fmaxf(v, __shfl_xor(v, o));
    return v;
}

using pg8::Unit;
struct Epi1 {
    static constexpr bool PERM = true, AFTER_DRAIN = false;
    const float* bias; bf16 *Q, *Kb, *Vb, *XB, *GY; float* out;
    __device__ __forceinline__ void operator()(const f32x4 (&acc)[2][2][4][2], const Unit& u, int wr, int wc, int fr, int fq) const {
        const int pn = u.pn;
#pragma unroll
        for (int bj = 0; bj < 2; ++bj) {
            const int gcol = pn * 256 + bj * 128 + wc * 32 + fq * 8;
            const f32x4 b0 = *(const f32x4*)(bias + gcol), b1 = *(const f32x4*)(bias + gcol + 4);
#pragma unroll
            for (int ai = 0; ai < 2; ++ai)
#pragma unroll
                for (int m = 0; m < 4; ++m) {
                    const int row = u.pm * 256 + ai * 128 + wr * 64 + m * 16 + fr;
                    f32x4 v0 = acc[ai][bj][m][0] + b0, v1 = acc[ai][bj][m][1] + b1;
                    if (pn < 2) {
                        store8(Q + (size_t)row * 512 + gcol, v0 * QSCALE, v1 * QSCALE);
                    } else if (pn == 2) {
                        const int c = wc * 32 + fq * 8;
                        store8((bj == 0 ? Kb : Vb) + (size_t)row * 128 + c, v0, v1);
                        float* o = nullptr;
                        if (row < NPROMPT) { const int t = row & 8191; if (t >= 8064) o = out + (bj == 0 ? O_KP : O_VP) + ((size_t)((row >> 13) * 128 + (t - 8064)) * 128 + c); }
                        else { const int r = row - NPROMPT; o = out + (bj == 0 ? O_KS : O_VS) + ((size_t)((r >> 2) * 128 + 124 + (r & 3)) * 128 + c); }
                        if (o) { *(f32x4*)o = v0; *(f32x4*)(o + 4) = v1; }
                    } else if (pn < 5) {
                        const int c = gcol - 768;
                        store8(XB + (size_t)row * 512 + c, v0, v1);
                        float* o = nullptr;
                        if (row < NPROMPT) { const int t = row & 8191; if (t >= 8189) o = out + O_CP + ((size_t)((row >> 13) * 3 + (t - 8189)) * 512 + c); }
                        else { const int r = row - NPROMPT, i = r & 3; if (i >= 1) o = out + O_CS + ((size_t)((r >> 2) * 3 + (i - 1)) * 512 + c); }
                        if (o) { *(f32x4*)o = v0; *(f32x4*)(o + 4) = v1; }
                    } else {
                        const int c = gcol - 1280;
#pragma unroll
                        for (int j = 0; j < 4; ++j) { v0[j] = gelu_tanh(v0[j]); v1[j] = gelu_tanh(v1[j]); }
                        store8(GY + (size_t)row * 512 + c, v0, v1);
                    }
                }
        }
    }
};
struct Epi2 {
    static constexpr bool PERM = false, AFTER_DRAIN = false;
    const float *xp, *xs, *bias; float* out; bf16* Hb; float* SS;
    __device__ __forceinline__ void operator()(const f32x4 (&acc)[2][2][4][2], const Unit& u, int wr, int wc, int fr, int fq) const {
        const int col0 = u.pn * 256 + wc * 32 + 4 * fq;
        f32x4 bv[2][2];
#pragma unroll
        for (int bj = 0; bj < 2; ++bj)
#pragma unroll
            for (int n = 0; n < 2; ++n) bv[bj][n] = *(const f32x4*)(bias + col0 + bj * 128 + n * 16);
#pragma unroll
        for (int ai = 0; ai < 2; ++ai)
#pragma unroll
            for (int m = 0; m < 4; ++m) {
                const int row = u.pm * 256 + ai * 128 + wr * 64 + m * 16 + fr;
                const float* xrow = row < NPROMPT ? xp + (size_t)row * 1024 : xs + (size_t)(row - NPROMPT) * 1024;
                float s = 0.f;
#pragma unroll
                for (int bj = 0; bj < 2; ++bj)
#pragma unroll
                    for (int n = 0; n < 2; ++n) {
                        const int c = col0 + bj * 128 + n * 16;
                        const f32x4 hv = acc[ai][bj][m][n] + bv[bj][n] + *(const f32x4*)(xrow + c);
                        *(f32x4*)(out + (size_t)row * 1024 + c) = hv;
                        u32x2 w; w.x = pk2(hv[0], hv[1]); w.y = pk2(hv[2], hv[3]); *(u32x2*)(Hb + (size_t)row * 1024 + c) = w;
                        s += (hv[0] * hv[0] + hv[1] * hv[1]) + (hv[2] * hv[2] + hv[3] * hv[3]);
                    }
                s += __shfl_xor(s, 16); s += __shfl_xor(s, 32);
                if (fq == 0) SS[(size_t)row * 16 + u.pn * 4 + wc] = s;
            }
    }
};
struct Epi3 {
    static constexpr bool PERM = true, AFTER_DRAIN = false;
    const float* SS; bf16* ACT;
    __device__ __forceinline__ void operator()(const f32x4 (&acc)[2][2][4][2], const Unit& u, int wr, int wc, int fr, int fq) const {
        const int j0 = u.pn * 128 + wc * 32 + fq * 8;
#pragma unroll
        for (int ai = 0; ai < 2; ++ai)
#pragma unroll
            for (int m = 0; m < 4; ++m) {
                const int row = u.pm * 256 + ai * 128 + wr * 64 + m * 16 + fr;
                const f32x4* sp = (const f32x4*)(SS + (size_t)row * 16);
                const f32x4 s0 = sp[0], s1 = sp[1], s2 = sp[2], s3 = sp[3];
                const float ss = ((s0[0] + s0[1]) + (s0[2] + s0[3])) + ((s1[0] + s1[1]) + (s1[2] + s1[3])) + ((s2[0] + s2[1]) + (s2[2] + s2[3])) + ((s3[0] + s3[1]) + (s3[2] + s3[3]));
                const float rstd = __builtin_amdgcn_rsqf(ss * (1.0f / 1024.0f) + EPS);
                f32x4 a[2];
#pragma unroll
                for (int n = 0; n < 2; ++n) {
                    const f32x4 g = acc[ai][0][m][n] * rstd, up = acc[ai][1][m][n] * rstd;
#pragma unroll
                    for (int j = 0; j < 4; ++j) a[n][j] = g[j] * fast_sigmoid(g[j]) * up[j];
                }
                store8(ACT + (size_t)row * D_FF + j0, a[0], a[1]);
            }
    }
};
struct Epi4 {
    static constexpr bool PERM = false, AFTER_DRAIN = false;
    float* out; float* SS;
    __device__ __forceinline__ void operator()(const f32x4 (&acc)[2][2][4][2], const Unit& u, int wr, int wc, int fr, int fq) const {
        const int col0 = u.pn * 256 + wc * 32 + 4 * fq;
#pragma unroll
        for (int ai = 0; ai < 2; ++ai)
#pragma unroll
            for (int m = 0; m < 4; ++m) {
                const int row = u.pm * 256 + ai * 128 + wr * 64 + m * 16 + fr;
                float s = 0.f;
#pragma unroll
                for (int bj = 0; bj < 2; ++bj)
#pragma unroll
                    for (int n = 0; n < 2; ++n) {
                        float* pp = out + (size_t)row * 1024 + col0 + bj * 128 + n * 16;
                        const f32x4 y = *(const f32x4*)pp + acc[ai][bj][m][n];
                        *(f32x4*)pp = y;
                        s += (y[0] * y[0] + y[1] * y[1]) + (y[2] * y[2] + y[3] * y[3]);
                    }
                s += __shfl_xor(s, 16); s += __shfl_xor(s, 32);
                if (fq == 0) SS[(size_t)row * 16 + u.pn * 4 + wc] = s;
            }
    }
};

__device__ __forceinline__ void transpose_item(const float* W, int K, int ldw, bf16* WT, int kb, int dst_n0, int src_n0, const float* g, LAS float* scr, int lane) {
    const int k0 = 64 * kb;
#pragma unroll 8
    for (int i = 0; i < 32; ++i) { const int kk = 2 * i + (lane >> 5); float v = W[(size_t)(k0 + kk) * ldw + src_n0 + (lane & 31)]; if (g) v *= g[k0 + kk]; scr[kk * 33 + (lane & 31)] = v; }
    asm volatile("s_waitcnt lgkmcnt(0)" ::: "memory");
    const int c = lane & 7;
#pragma unroll
    for (int j = 0; j < 4; ++j) { const int n = (lane >> 3) + 8 * j; const LAS float* s = scr + (8 * c) * 33 + n;
        u32x4 o; o.x = pk2(s[0 * 33], s[1 * 33]); o.y = pk2(s[2 * 33], s[3 * 33]); o.z = pk2(s[4 * 33], s[5 * 33]); o.w = pk2(s[6 * 33], s[7 * 33]);
        *(u32x4*)(WT + (size_t)(dst_n0 + n) * K + k0 + 8 * c) = o; }
    asm volatile("s_waitcnt lgkmcnt(0)" ::: "memory");
}
__device__ __forceinline__ void p0_prologue(const Params& p, LAS unsigned char* lds, int tid, int wave, int lane) {
    unsigned char* ws = p.ws;
    LAS float* scr = (LAS float*)(lds + wave * 16384);
    const int gw = blockIdx.x * 8 + wave, NGW = gridDim.x * 8;
    constexpr int I_IN = 16 * 56, I_OUT = 16 * 32, I_FI = 16 * 176, I_FO = 44 * 32, NITEMS = I_IN + I_OUT + I_FI + I_FO;
    for (int it = gw; it < NITEMS; it += NGW) {
        int r = it;
        if (r < I_IN) { const int kb = r / 56, nb = r % 56; transpose_item(p.in[7], 1024, IN_W, (bf16*)(ws + WS_WIN), kb, 32 * nb, 32 * nb, nullptr, scr, lane); continue; } r -= I_IN;
        if (r < I_OUT) { const int kb = r / 32, nb = r % 32; transpose_item(p.in[17], 1024, 1024, (bf16*)(ws + WS_WOUT), kb, 32 * nb, 32 * nb, nullptr, scr, lane); continue; } r -= I_OUT;
        if (r < I_FI) { const int kb = r / 176, nb = r % 176; const int d0 = 32 * nb, pn = d0 >> 8, bj = (d0 >> 7) & 1, i0 = d0 & 127;
            transpose_item(p.in[20], 1024, 2 * D_FF, (bf16*)(ws + WS_WFI), kb, d0, bj * D_FF + 128 * pn + i0, p.in[19], scr, lane); continue; } r -= I_FI;
        { const int kb = r / 32, nb = r % 32; transpose_item(p.in[21], D_FF, 1024, (bf16*)(ws + WS_WFO), kb, 32 * nb, 32 * nb, nullptr, scr, lane); }
    }
    const int gt = blockIdx.x * 512 + tid, NGT = gridDim.x * 512;
    for (int idx = gt; idx < 2 * 32768; idx += NGT) {
        const int which = idx >> 15, r = idx & 32767, n = r >> 12, e = (r >> 6) & 63, d = r & 63;
        const float v = (which ? p.in[14] : p.in[12])[n * 4096 + d * 64 + e];
        ((bf16*)(ws + (which ? WS_WI : WS_WA)))[r] = f2bf(v);
    }
    for (int idx = gt; idx < 2 * 128 * 3968; idx += NGT) {
        const int which = idx / (128 * 3968), r = idx % (128 * 3968), sb = r / 3968, e = r % 3968;
        const f32x4 v = *(const f32x4*)((which ? p.in[3] : p.in[2]) + (size_t)sb * 16384 + 512 + 4 * e);
        *(f32x4*)(p.out + (which ? O_VS : O_KS) + (size_t)sb * 16384 + 4 * e) = v;
    }
    const float* gm = p.in[6];
    f32x4 gv[4];
#pragma unroll
    for (int j = 0; j < 4; ++j) gv[j] = *(const f32x4*)(gm + 256 * j + 4 * lane);
    bf16* XN = (bf16*)(ws + WS_XN);
    for (int row = gw; row < MROWS; row += NGW) {
        const float* xr = row < NPROMPT ? p.in[0] + (size_t)row * 1024 : p.in[1] + (size_t)(row - NPROMPT) * 1024;
        f32x4 v[4]; float s = 0.f;
#pragma unroll
        for (int j = 0; j < 4; ++j) { v[j] = *(const f32x4*)(xr + 256 * j + 4 * lane); s += (v[j][0] * v[j][0] + v[j][1] * v[j][1]) + (v[j][2] * v[j][2] + v[j][3] * v[j][3]); }
        const float rstd = __builtin_amdgcn_rsqf(wave_sum(s) * (1.0f / 1024.0f) + EPS);
#pragma unroll
        for (int j = 0; j < 4; ++j) { const f32x4 o = v[j] * rstd * gv[j]; u32x2 w; w.x = pk2(o[0], o[1]); w.y = pk2(o[2], o[3]); *(u32x2*)(XN + (size_t)row * 1024 + 256 * j + 4 * lane) = w; }
    }
}

__device__ __forceinline__ void attn_prompt_unit(const Params& p, LAS unsigned char* lds, int unit, int tid, int wave, int lane) {
    const int kvh = unit & 1, nb = (unit >> 1) & 63, b = unit >> 7;
    const bf16* Qb = (const bf16*)(p.ws + WS_Q); const bf16* Kb = (const bf16*)(p.ws + WS_K); const bf16* Vb = (const bf16*)(p.ws + WS_V); bf16* MIX = (bf16*)(p.ws + WS_MIX);
    LAS unsigned char* Ks = lds; LAS unsigned char* Vs = lds + 36864;
    const int rowbase = b * SEQ + nb * 128;
#pragma unroll
    for (int i = 0; i < 4; ++i) {
        const int idx = tid + 512 * i, jr = idx >> 3, ck = idx & 7; const int grow = rowbase - 128 + jr;
        u32x4 kv = {0u, 0u, 0u, 0u}, vv = {0u, 0u, 0u, 0u};
        if (nb > 0 || jr >= 128) { kv = *(const u32x4*)(Kb + (size_t)grow * 128 + kvh * 64 + ck * 8); vv = *(const u32x4*)(Vb + (size_t)grow * 128 + kvh * 64 + ck * 8); }
        *(LAS u32x4*)(Ks + jr * 144 + ck * 16) = kv; *(LAS u32x4*)(Vs + jr * 192 + ck * 16) = vv;
    }
    __syncthreads();
    const int g = wave & 3, hh = kvh * 4 + g, c = lane & 31, h = lane >> 5;
    const float slope2 = exp2f(-(float)(hh + 1)) * LOG2E, sink2 = p.in[9][hh] * LOG2E;
#pragma unroll 1
    for (int ci = 0; ci < 2; ++ci) {
        const int r0 = 32 * ((wave >> 2) * 2 + ci);
        bf16x8 qf[4];
#pragma unroll
        for (int s = 0; s < 4; ++s) qf[s] = *(const bf16x8*)(Qb + (size_t)(rowbase + r0 + c) * 512 + hh * 64 + 16 * s + 8 * h);
        f32x16 S[5];
#pragma unroll
        for (int kt = 0; kt < 5; ++kt) {
#pragma unroll
            for (int r = 0; r < 16; ++r) S[kt][r] = 0.f;
#pragma unroll
            for (int s = 0; s < 4; ++s) { const bf16x8 kf = *(const LAS bf16x8*)(Ks + (r0 + 32 * kt + c) * 144 + (16 * s + 8 * h) * 2); S[kt] = __builtin_amdgcn_mfma_f32_32x32x16_bf16(kf, qf[s], S[kt], 0, 0, 0); }
        }
        float m = sink2;
        int base = 128 + c - 4 * h;
        asm volatile("" : "+v"(base));
        const float t0 = -slope2 * (float)base;
#pragma unroll
        for (int kt = 0; kt < 5; ++kt)
#pragma unroll
            for (int r = 0; r < 16; ++r) {
                const int K = 32 * kt + (r & 3) + 8 * (r >> 2);
                float sv = __builtin_fmaf(slope2, (float)K, S[kt][r] + t0);
                if (kt == 0) sv = (base - K < 128) ? sv : -1e30f;
                if (kt == 4) sv = (base - K >= 0) ? sv : -1e30f;
                S[kt][r] = sv;
            }
        if (nb == 0) {
#pragma unroll
            for (int kt = 0; kt < 5; ++kt)
#pragma unroll
                for (int r = 0; r < 16; ++r) { const int K = 32 * kt + (r & 3) + 8 * (r >> 2); if (r0 + 4 * h + K < 128) S[kt][r] = -1e30f; }
        }
#pragma unroll
        for (int kt = 0; kt < 5; ++kt)
#pragma unroll
            for (int r = 0; r < 16; ++r) m = fmaxf(m, S[kt][r]);
        m = fmaxf(m, __shfl_xor(m, 32));
        float l = 0.f;
#pragma unroll
        for (int kt = 0; kt < 5; ++kt)
#pragma unroll
            for (int r = 0; r < 16; ++r) { const float pv = __builtin_amdgcn_exp2f(S[kt][r] - m); S[kt][r] = pv; l += pv; }
        l += __shfl_xor(l, 32); l += __builtin_amdgcn_exp2f(sink2 - m);
        const float inv = 1.0f / l;
        f32x16 O0, O1;
#pragma unroll
        for (int r = 0; r < 16; ++r) { O0[r] = 0.f; O1[r] = 0.f; }
        const int vlane = ((lane & 15) >> 2) * 192 + (16 * ((lane >> 4) & 1) + 4 * (lane & 3)) * 2 + 4 * h * 192;
#pragma unroll
        for (int kt = 0; kt < 5; ++kt)
#pragma unroll
            for (int s = 0; s < 2; ++s) {
                u32x4 pw;
                pw.x = pk2(S[kt][8 * s + 0] * inv, S[kt][8 * s + 1] * inv); pw.y = pk2(S[kt][8 * s + 2] * inv, S[kt][8 * s + 3] * inv);
                pw.z = pk2(S[kt][8 * s + 4] * inv, S[kt][8 * s + 5] * inv); pw.w = pk2(S[kt][8 * s + 6] * inv, S[kt][8 * s + 7] * inv);
                const bf16x8 pa = __builtin_bit_cast(bf16x8, pw);
                const int kb = r0 + 32 * kt + 16 * s;
#pragma unroll
                for (int nt = 0; nt < 2; ++nt) {
                    const s16x4 v0 = __builtin_amdgcn_ds_read_tr16_b64_v4i16((LAS s16x4*)(Vs + kb * 192 + vlane + nt * 64));
                    const s16x4 v1 = __builtin_amdgcn_ds_read_tr16_b64_v4i16((LAS s16x4*)(Vs + (kb + 8) * 192 + vlane + nt * 64));
                    bf16x8 vb; vb[0] = v0[0]; vb[1] = v0[1]; vb[2] = v0[2]; vb[3] = v0[3]; vb[4] = v1[0]; vb[5] = v1[1]; vb[6] = v1[2]; vb[7] = v1[3];
                    if (nt == 0) O0 = __builtin_amdgcn_mfma_f32_32x32x16_bf16(pa, vb, O0, 0, 0, 0); else O1 = __builtin_amdgcn_mfma_f32_32x32x16_bf16(pa, vb, O1, 0, 0, 0);
                }
                asm volatile("" ::: "memory");
            }
#pragma unroll
        for (int r = 0; r < 16; ++r) {
            const int qrow = r0 + (r & 3) + 8 * (r >> 2) + 4 * h;
            bf16* o = MIX + (size_t)(rowbase + qrow) * 1024 + hh * 64 + c;
            o[0] = f2bf(O0[r]); o[32] = f2bf(O1[r]);
        }
    }
    __syncthreads();
}

__device__ __forceinline__ void attn_sample_unit(const Params& p, LAS unsigned char* lds, int unit, int tid, int wave, int lane) {
    const int kvh = unit & 1, sb = unit >> 1;
    const bf16* Qb = (const bf16*)(p.ws + WS_Q); bf16* MIX = (bf16*)(p.ws + WS_MIX);
    LAS float* Kf = (LAS float*)lds; LAS float* Vf = Kf + 132 * 65; LAS float* Qf = Vf + 132 * 64; LAS float* Pf = Qf + 1024;
    for (int i = 0; i < 17; ++i) {
        const int idx = tid + 512 * i;
        if (idx < 132 * 64) {
            const int j = idx >> 6, d = idx & 63; float kv, vv;
            if (j < 4) { const size_t o = ((size_t)(sb * 128 + j) * 2 + kvh) * 64 + d; kv = p.in[2][o]; vv = p.in[3][o]; }
            else { const size_t o = (size_t)(sb * 128 + j - 4) * 128 + kvh * 64 + d; kv = p.out[O_KS + o]; vv = p.out[O_VS + o]; }
            Kf[j * 65 + d] = kv; Vf[j * 64 + d] = vv;
        }
    }
#pragma unroll
    for (int i = 0; i < 2; ++i) { const int idx = tid + 512 * i, rr = idx >> 6, d = idx & 63;
        Qf[idx] = bf2f(Qb[(size_t)(NPROMPT + sb * 4 + (rr & 3)) * 512 + (kvh * 4 + (rr >> 2)) * 64 + d]); }
    __syncthreads();
#pragma unroll 1
    for (int r2 = 0; r2 < 2; ++r2) {
        const int rr = wave * 2 + r2, g = rr >> 2, it = rr & 3, hh = kvh * 4 + g;
        const float slope2 = exp2f(-(float)(hh + 1)) * LOG2E, sink2 = p.in[9][hh] * LOG2E;
        float sc[3]; float m = sink2;
#pragma unroll
        for (int kk = 0; kk < 3; ++kk) {
            const int j = lane + 64 * kk, jj = j < 132 ? j : 131; float s = 0.f;
#pragma unroll 8
            for (int d = 0; d < 64; ++d) s += Qf[rr * 64 + d] * Kf[jj * 65 + d];
            const int dist = 128 + it - j; const bool valid = (j < 132) && (dist >= 0) && (dist < 128);
            sc[kk] = valid ? s - slope2 * (float)dist : -1e30f; m = fmaxf(m, sc[kk]);
        }
        m = wave_max(m);
        float l = 0.f;
#pragma unroll
        for (int kk = 0; kk < 3; ++kk) { sc[kk] = __builtin_amdgcn_exp2f(sc[kk] - m); l += sc[kk]; }
        l = wave_sum(l) + __builtin_amdgcn_exp2f(sink2 - m);
        const float inv = 1.0f / l;
#pragma unroll
        for (int kk = 0; kk < 3; ++kk) { const int j = lane + 64 * kk; if (j < 132) Pf[wave * 136 + j] = sc[kk] * inv; }
        __syncthreads();
        float o = 0.f;
#pragma unroll 4
        for (int j = 0; j < 132; ++j) o += Pf[wave * 136 + j] * Vf[j * 64 + lane];
        MIX[(size_t)(NPROMPT + sb * 4 + it) * 1024 + hh * 64 + lane] = f2bf(o);
        __syncthreads();
    }
}

template <int MODE>
__device__ __forceinline__ void lru_unit(const Params& p, LAS unsigned char* lds, int unit, int wave, int lane) {
    const int n = wave, cp = lane & 31, th = lane >> 5, c = lane & 31, h = lane >> 5;
    LAS unsigned char* xcs = lds + wave * 9216;
    const bf16* XB = (const bf16*)(p.ws + WS_XB); const bf16* GY = (const bf16*)(p.ws + WS_GY); bf16* MIX = (bf16*)(p.ws + WS_MIX);
    const bf16* WA = (const bf16*)(p.ws + WS_WA); const bf16* WI = (const bf16*)(p.ws + WS_WI);
    float* SUMA = (float*)(p.ws + WS_SUMA); float* SUMB = (float*)(p.ws + WS_SUMB);
    const int b = unit >> 7, chunk = unit & 127;
    const int rowbase = MODE < 2 ? b * SEQ + chunk * 64 : NPROMPT + unit * 32;
    {
        const int ch2 = n * 64 + 2 * cp;
        const float* cw = p.in[10]; const float* cb = p.in[11];
        const float w0a = cw[ch2], w0b = cw[ch2 + 1], w1a = cw[512 + ch2], w1b = cw[512 + ch2 + 1], w2a = cw[1024 + ch2], w2b = cw[1024 + ch2 + 1], w3a = cw[1536 + ch2], w3b = cw[1536 + ch2 + 1];
        const float bia = cb[ch2], bib = cb[ch2 + 1];
        if (MODE < 2) {
            const int tl0 = th * 32;
            float xa[3], xb[3];
#pragma unroll
            for (int i = 0; i < 3; ++i) {
                const int tl = tl0 - 3 + i; unsigned v = 0u;
                if (chunk > 0 || tl >= 0) v = *(const unsigned*)(XB + (size_t)(rowbase + tl) * 512 + ch2);
                xa[i] = bf2f((unsigned short)(v & 0xffffu)); xb[i] = bf2f((unsigned short)(v >> 16));
            }
#pragma unroll
            for (int t = 0; t < 32; ++t) {
                const unsigned v = *(const unsigned*)(XB + (size_t)(rowbase + tl0 + t) * 512 + ch2);
                const float x3a = bf2f((unsigned short)(v & 0xffffu)), x3b = bf2f((unsigned short)(v >> 16));
                const float ya = bia + w0a * xa[0] + w1a * xa[1] + w2a * xa[2] + w3a * x3a, yb = bib + w0b * xb[0] + w1b * xb[1] + w2b * xb[2] + w3b * x3b;
                *(LAS unsigned*)(xcs + (tl0 + t) * 144 + cp * 4) = pk2(ya, yb);
                xa[0] = xa[1]; xa[1] = xa[2]; xa[2] = x3a; xb[0] = xb[1]; xb[1] = xb[2]; xb[2] = x3b;
            }
        } else {
            const float* sc = p.in[4];
#pragma unroll
            for (int q = 0; q < 4; ++q) {
                const int bi = th * 4 + q, sb = unit * 8 + bi;
                float ia[7], ib[7];
#pragma unroll
                for (int i = 0; i < 3; ++i) { ia[i] = sc[(size_t)(sb * 3 + i) * 512 + ch2]; ib[i] = sc[(size_t)(sb * 3 + i) * 512 + ch2 + 1]; }
#pragma unroll
                for (int i = 0; i < 4; ++i) { const unsigned v = *(const unsigned*)(XB + (size_t)(rowbase + bi * 4 + i) * 512 + ch2); ia[3 + i] = bf2f((unsigned short)(v & 0xffffu)); ib[3 + i] = bf2f((unsigned short)(v >> 16)); }
#pragma unroll
                for (int i = 0; i < 4; ++i) {
                    const float ya = bia + w0a * ia[i] + w1a * ia[i + 1] + w2a * ia[i + 2] + w3a * ia[i + 3], yb = bib + w0b * ib[i] + w1b * ib[i + 1] + w2b * ib[i + 2] + w3b * ib[i + 3];
                    *(LAS unsigned*)(xcs + (bi * 4 + i) * 144 + cp * 4) = pk2(ya, yb);
                }
            }
        }
    }
    float hin = 0.f;
    if (MODE == 1) {
        const float* sa = SUMA + (size_t)(b * 128) * 512 + n * 64 + lane; const float* sbp = SUMB + (size_t)(b * 128) * 512 + n * 64 + lane;
        int j = 0;
        for (; j + 8 <= chunk; j += 8) {
            float aa[8], bb[8];
#pragma unroll
            for (int q = 0; q < 8; ++q) { aa[q] = sa[(size_t)(j + q) * 512]; bb[q] = sbp[(size_t)(j + q) * 512]; }
#pragma unroll
            for (int q = 0; q < 8; ++q) hin = aa[q] * hin + bb[q];
        }
        for (; j < chunk; ++j) hin = sa[(size_t)j * 512] * hin + sbp[(size_t)j * 512];
    }
    __syncthreads();
#pragma unroll 1
    for (int et = 0; et < 2; ++et) {
        const int chl = et * 32 + c, ch = n * 64 + chl;
        const float ba = p.in[13][ch], bi_ = p.in[15][ch], lam = p.in[16][ch];
        const float sp8 = 8.0f * log1pf(__expf(-lam));
        bf16x8 wa[4], wi[4];
#pragma unroll
        for (int s = 0; s < 4; ++s) { wa[s] = *(const bf16x8*)(WA + (size_t)(n * 64 + chl) * 64 + 16 * s + 8 * h); wi[s] = *(const bf16x8*)(WI + (size_t)(n * 64 + chl) * 64 + 16 * s + 8 * h); }
        float hcar = MODE == 1 ? __shfl(hin, chl) : 0.f;
        float Atot = 1.f;
#pragma unroll 1
        for (int tt = 0; tt < (MODE == 2 ? 1 : 2); ++tt) {
            f32x16 accA, accI;
#pragma unroll
            for (int r = 0; r < 16; ++r) { accA[r] = 0.f; accI[r] = 0.f; }
#pragma unroll
            for (int s = 0; s < 4; ++s) {
                const bf16x8 af = *(const LAS bf16x8*)(xcs + (tt * 32 + c) * 144 + (16 * s + 8 * h) * 2);
                accA = __builtin_amdgcn_mfma_f32_32x32x16_bf16(af, wa[s], accA, 0, 0, 0);
                accI = __builtin_amdgcn_mfma_f32_32x32x16_bf16(af, wi[s], accI, 0, 0, 0);
            }
            float av[16], bv[16];
#pragma unroll
            for (int r = 0; r < 16; ++r) {
                const int tok = tt * 32 + (r & 3) + 8 * (r >> 2) + 4 * h;
                const float xcv = bf2f(*(const LAS unsigned short*)(xcs + tok * 144 + chl * 2));
                const float rg = fast_sigmoid(accA[r] + ba), ig = fast_sigmoid(accI[r] + bi_);
                const float a = __expf(-sp8 * rg);
                av[r] = a; bv[r] = sqrtf(fmaxf(1.0f - a * a, 0.f)) * ig * xcv;
            }
            if (MODE < 2) {
                float Ae[4], Be[4], Ao[4], Bo[4];
#pragma unroll
                for (int g = 0; g < 4; ++g) {
                    const float A = (av[4 * g] * av[4 * g + 1]) * (av[4 * g + 2] * av[4 * g + 3]);
                    const float B = ((bv[4 * g] * av[4 * g + 1] + bv[4 * g + 1]) * av[4 * g + 2] + bv[4 * g + 2]) * av[4 * g + 3] + bv[4 * g + 3];
                    const float pA = __shfl_xor(A, 32), pB = __shfl_xor(B, 32);
                    Ae[g] = h ? pA : A; Be[g] = h ? pB : B; Ao[g] = h ? A : pA; Bo[g] = h ? B : pB;
                }
                float hs[4]; float x = hcar;
#pragma unroll
                for (int g = 0; g < 4; ++g) { const float he = x; x = Ae[g] * x + Be[g]; const float ho = x; x = Ao[g] * x + Bo[g]; hs[g] = h ? ho : he; Atot *= Ae[g] * Ao[g]; }
                hcar = x;
                if (MODE == 1) {
#pragma unroll
                    for (int g = 0; g < 4; ++g) {
                        float y = hs[g];
#pragma unroll
                        for (int i = 0; i < 4; ++i) {
                            y = av[4 * g + i] * y + bv[4 * g + i];
                            const int row = rowbase + tt * 32 + 8 * g + 4 * h + i;
                            const float gy = bf2f(GY[(size_t)row * 512 + ch]);
                            MIX[(size_t)row * 1024 + 512 + ch] = f2bf(y * gy);
                        }
                    }
                }
            } else {
#pragma unroll
                for (int g = 0; g < 4; ++g) {
                    const int sb = unit * 8 + 2 * g + h;
                    float y = p.in[5][(size_t)sb * 512 + ch];
#pragma unroll
                    for (int i = 0; i < 4; ++i) {
                        y = av[4 * g + i] * y + bv[4 * g + i];
                        const int row = rowbase + 8 * g + 4 * h + i;
                        const float gy = bf2f(GY[(size_t)row * 512 + ch]);
                        MIX[(size_t)row * 1024 + 512 + ch] = f2bf(y * gy);
                    }
                    p.out[O_HS + (size_t)sb * 512 + ch] = y;
                }
            }
        }
        if (MODE == 0 && h == 0) { SUMA[(size_t)(b * 128 + chunk) * 512 + ch] = Atot; SUMB[(size_t)(b * 128 + chunk) * 512 + ch] = hcar; }
        if (MODE == 1 && chunk == 127 && h == 0) p.out[O_HP + (size_t)b * 512 + ch] = hcar;
    }
    __syncthreads();
}

__global__ void __launch_bounds__(512, 2) fwd(Params p) {
    extern __shared__ __attribute__((aligned(16))) unsigned char lds_raw[];
    LAS unsigned char* lds = (LAS unsigned char*)lds_raw;
    const int tid = threadIdx.x, lane = tid & 63, wave = __builtin_amdgcn_readfirstlane(tid >> 6);
    const int lo = p.ph_lo, hi = p.ph_hi, G = gridDim.x;
    unsigned char* ws = p.ws;
#ifdef ONLY_PH
#define IN_PH(k) ((k) == ONLY_PH)
#else
#define IN_PH(k) (lo <= (k) && (k) < hi)
#endif
#define SEAM(k) do { if (lo <= (k) && (k) + 1 < hi) cg::this_grid().sync(); } while (0)

    if (IN_PH(0)) { p0_prologue(p, lds, tid, wave, lane); }
    SEAM(0);
    if (IN_PH(1)) {
        pg8::Gemm g{(const bf16*)(ws + WS_XN), (const bf16*)(ws + WS_WIN), MROWS, IN_W, 1024}; pg8::StaticOrder S; S.init(MROWS, IN_W, G, (int)blockIdx.x);
        Epi1 E{p.in[8], (bf16*)(ws + WS_Q), (bf16*)(ws + WS_K), (bf16*)(ws + WS_V), (bf16*)(ws + WS_XB), (bf16*)(ws + WS_GY), p.out};
        pg8::gemm_phase<Epi1, pg8::StaticOrder, true, true>(lds, g, S, E);
    }
    SEAM(1);
    if (IN_PH(2)) {
        for (int u = blockIdx.x; u < 1280; u += G) {
            if (u < 512) attn_prompt_unit(p, lds, u, tid, wave, lane);
            else if (u < 1024) lru_unit<0>(p, lds, u - 512, wave, lane);
            else attn_sample_unit(p, lds, u - 1024, tid, wave, lane);
        }
    }
    SEAM(2);
    if (IN_PH(3)) {
        for (int u = blockIdx.x; u < 528; u += G) {
            if (u < 512) lru_unit<1>(p, lds, u, wave, lane);
            else lru_unit<2>(p, lds, u - 512, wave, lane);
        }
    }
    SEAM(3);
    if (IN_PH(4)) {
        pg8::Gemm g{(const bf16*)(ws + WS_MIX), (const bf16*)(ws + WS_WOUT), MROWS, 1024, 1024}; pg8::StaticOrder S; S.init(MROWS, 1024, G, (int)blockIdx.x);
        Epi2 E{p.in[0], p.in[1], p.in[18], p.out, (bf16*)(ws + WS_HB), (float*)(ws + WS_SS2)};
        pg8::gemm_phase<Epi2, pg8::StaticOrder, true, true>(lds, g, S, E);
    }
    SEAM(4);
    if (IN_PH(5)) {
        pg8::Gemm g{(const bf16*)(ws + WS_HB), (const bf16*)(ws + WS_WFI), MROWS, 2 * D_FF, 1024}; pg8::StaticOrder S; S.init(MROWS, 2 * D_FF, G, (int)blockIdx.x);
        Epi3 E{(const float*)(ws + WS_SS2), (bf16*)(ws + WS_ACT)};
        pg8::gemm_phase<Epi3, pg8::StaticOrder, true, true>(lds, g, S, E);
    }
    SEAM(5);
    if (IN_PH(6)) {
        pg8::Gemm g{(const bf16*)(ws + WS_ACT), (const bf16*)(ws + WS_WFO), MROWS, 1024, D_FF}; pg8::StaticOrder S; S.init(MROWS, 1024, G, (int)blockIdx.x);
        Epi4 E{p.out, (float*)(ws + WS_SS3)};
        pg8::gemm_phase<Epi4, pg8::StaticOrder, true, true>(lds, g, S, E);
    }
    SEAM(6);
    if (IN_PH(7)) {
        const float* gf = p.in[22]; const float* SS = (const float*)(ws + WS_SS3);
        f32x4 gv[4];
#pragma unroll
        for (int j = 0; j < 4; ++j) gv[j] = *(const f32x4*)(gf + 256 * j + 4 * lane);
        for (int row = blockIdx.x * 8 + wave; row < MROWS; row += G * 8) {
            const f32x4* sp = (const f32x4*)(SS + (size_t)row * 16);
            const f32x4 s0 = sp[0], s1 = sp[1], s2 = sp[2], s3 = sp[3];
            const float ss = ((s0[0] + s0[1]) + (s0[2] + s0[3])) + ((s1[0] + s1[1]) + (s1[2] + s1[3])) + ((s2[0] + s2[1]) + (s2[2] + s2[3])) + ((s3[0] + s3[1]) + (s3[2] + s3[3]));
            const float rstd = __builtin_amdgcn_rsqf(ss * (1.0f / 1024.0f) + EPS);
            float* yr = p.out + (size_t)row * 1024;
#pragma unroll
            for (int j = 0; j < 4; ++j) { f32x4* q = (f32x4*)(yr + 256 * j + 4 * lane); *q = *q * rstd * gv[j]; }
        }
    }
}

#ifndef N_LAUNCH_MODE
#define N_LAUNCH_MODE 1
#endif
extern "C" void kernel_launch(void* const* d_in, const int* in_sizes, int n_in, void* d_out, int out_size, void* d_ws, size_t ws_size, hipStream_t stream) {
    static int grid = 0;
    if (!grid) {
        if (n_in != 23 || ws_size < WS_END) { fprintf(stderr, "kernel_launch: unexpected n_in %d / ws_size %zu\n", n_in, ws_size); return; }
        int dev = 0, cus = 0, per_cu = 0;
        hipGetDevice(&dev); hipDeviceGetAttribute(&cus, hipDeviceAttributeMultiprocessorCount, dev);
        hipFuncSetAttribute((const void*)fwd, hipFuncAttributeMaxDynamicSharedMemorySize, LDS_BYTES);
        hipOccupancyMaxActiveBlocksPerMultiprocessor(&per_cu, fwd, 512, LDS_BYTES);
        if (per_cu < 1) { fprintf(stderr, "kernel_launch: occupancy query says %d blocks per CU\n", per_cu); per_cu = 1; }
        grid = cus;
    }
    Params p{};
    for (int i = 0; i < 23; ++i) p.in[i] = (const float*)d_in[i];
    p.out = (float*)d_out; p.ws = (unsigned char*)d_ws;
    if (N_LAUNCH_MODE == 1) {
        p.ph_lo = 0; p.ph_hi = 8;
        void* args[] = {&p};
        hipError_t e = hipLaunchCooperativeKernel((const void*)fwd, dim3(grid), dim3(512), args, LDS_BYTES, stream);
        if (e != hipSuccess) fprintf(stderr, "cooperative launch failed: %s (grid %d)\n", hipGetErrorString(e), grid);
    } else {
        for (int ph = 0; ph < 8; ++ph) { p.ph_lo = ph; p.ph_hi = ph + 1; hipLaunchKernelGGL(fwd, dim3(grid), dim3(512), LDS_BYTES, stream, p); }
    }
}
```

```cpp
#include <hip/hip_runtime.h>
#include <hip/hip_cooperative_groups.h>
#include <cstdio>
#include <cstdint>
namespace cg = cooperative_groups;
namespace pg8 {
#define PG8_LAS __attribute__((address_space(3)))
typedef unsigned short bf16_t;
typedef short bf16x8 __attribute__((ext_vector_type(8)));
typedef float f32x4 __attribute__((ext_vector_type(4)));
typedef unsigned u32x4 __attribute__((ext_vector_type(4)));
constexpr int BM = 256, BK = 64, HALF = 128, HTB = HALF * BK * 2  , STAGE_BYTES = 8 * HTB, NXCD = 8, WGM = 8;

__host__ __device__ __forceinline__ int lds_byte(int r, int c) { const int st = (r >> 4) * 2 + (c >> 5), rr = r & 15, cc = c & 31, ob = rr * 64 + cc * 2; return st * 1024 + (ob ^ (((ob >> 9) & 1) << 5)); }
__host__ __device__ __forceinline__ void stage_rc(int b, int& R, int& C) { const int st = b / 1024, sb = b % 1024, swz = sb ^ (((sb >> 9) & 1) << 5); R = (st >> 1) * 16 + swz / 64; C = (st & 1) * 32 + (swz % 64) / 2; }
__host__ __device__ __forceinline__ int perm32(int rho) { const int n = rho >> 4, i = rho & 15; return 8 * (i >> 2) + 4 * n + (i & 3); }

struct Unit { int pm, pn; };
struct Gemm { const bf16_t* A; const bf16_t* Bt; int M, N, K; };

struct StaticOrder {
    int nM, nN, nwg, G, c;
    __host__ __device__ void init(int M, int N, int G_, int c_) { nM = M / BM; nN = N / BM; nwg = nM * nN; G = G_; c = c_; }
    __host__ __device__ bool next(int i, Unit& u) const {
        const long L = (long)i * G + c; if (L >= nwg) return false;
        int wgid = (int)L; { const int q = nwg / NXCD, r = nwg % NXCD, xcd = wgid % NXCD, off = wgid / NXCD; wgid = (xcd < r ? xcd * (q + 1) : r * (q + 1) + (xcd - r) * q) + off; }
        const int nig = WGM * nN, gid = wgid / nig, fm = gid * WGM, gsz = (nM - fm) < WGM ? (nM - fm) : WGM;
        u.pm = fm + ((wgid % nig) % gsz); u.pn = (wgid % nig) / gsz; return true;
    }
    __device__ __forceinline__ void a_ready(const Unit&) const {}
    __device__ __forceinline__ void done(const Unit&) const {}
};
__device__ __forceinline__ unsigned cvt_pk_bf16(float lo, float hi) { unsigned r; asm volatile("v_cvt_pk_bf16_f32 %0, %1, %2" : "=v"(r) : "v"(lo), "v"(hi)); return r; }
template <class Epi, class Sched, bool ALIGN_EPI = false, bool SP2 = false>
__device__ __forceinline__ void gemm_phase(PG8_LAS unsigned char* lds, const Gemm g, const Sched& S, const Epi& E) {
    const int tid = threadIdx.x, wid = __builtin_amdgcn_readfirstlane(tid >> 6), lane = tid & 63, wr = wid >> 2, wc = wid & 3, fr = lane & 15, fq = lane >> 4;
    const int K = g.K, nt = K / BK;
    unsigned voffA[2], voffB[2];
#pragma unroll
    for (int i = 0; i < 2; ++i) { int R, C; stage_rc(tid * 16 + i * 8192, R, C); const int Rb = Epi::PERM ? ((R & ~31) + perm32(R & 31)) : R;
        voffA[i] = (unsigned)(R * K + C) * 2u; voffB[i] = (unsigned)(Rb * K + C) * 2u; }
    const size_t kstep = (size_t)(BK * 2);
    const size_t hstep = (size_t)HALF * K * 2;
    const size_t tstep = 2 * hstep;
    const unsigned ldsw = (unsigned)wid * 1024u;
    const int aoff = lds_byte(wr * 64 + fr, fq * 8), boff = lds_byte(wc * 32 + fr, fq * 8);
#define PG8_SA(b, h) (((b) * 2 + (h)) * HTB)
#define PG8_SB(b, h) ((4 + (b) * 2 + (h)) * HTB)
#define PG8_STAGE(bufoff, gbase, voff) do { _Pragma("unroll") for (int _i = 0; _i < 2; ++_i) \
        __builtin_amdgcn_global_load_lds((const unsigned*)((const char*)(gbase) + (voff)[_i]), (PG8_LAS unsigned*)(lds + (bufoff) + ldsw + _i * 8192), 16, 0, 0); } while (0)
#define PG8_LDA(dst, b, h) do { _Pragma("unroll") for (int m = 0; m < 4; ++m) _Pragma("unroll") for (int k = 0; k < 2; ++k) dst[m][k] = *(const PG8_LAS bf16x8*)(lds + PG8_SA(b, h) + aoff + m * 2048 + k * 1024); } while (0)
#define PG8_LDB(dst, b, h) do { _Pragma("unroll") for (int n = 0; n < 2; ++n) _Pragma("unroll") for (int k = 0; k < 2; ++k) dst[n][k] = *(const PG8_LAS bf16x8*)(lds + PG8_SB(b, h) + boff + n * 2048 + k * 1024); } while (0)
#define PG8_MMA(ai, bj, At, Bt) do { __builtin_amdgcn_s_setprio(1); _Pragma("unroll") for (int m = 0; m < 4; ++m) _Pragma("unroll") for (int n = 0; n < 2; ++n) _Pragma("unroll") for (int k = 0; k < 2; ++k) \
        acc[ai][bj][m][n] = __builtin_amdgcn_mfma_f32_16x16x32_bf16(Bt[n][k], At[m][k], acc[ai][bj][m][n], 0, 0, 0); __builtin_amdgcn_s_setprio(0); } while (0)
#define PG8_WAIT_V(n) asm volatile("s_waitcnt vmcnt(" #n ")" ::: "memory")
#define PG8_WAIT_L(n) asm volatile("s_waitcnt lgkmcnt(" #n ")" ::: "memory")
#define PG8_BAR __builtin_amdgcn_s_barrier()
#define PG8_SCHED __builtin_amdgcn_sched_barrier(0)
    Unit cur, nxt; int ui = 0;
    if (!S.next(0, cur)) return;
    f32x4 acc[2][2][4][2];
#pragma unroll
    for (int a = 0; a < 2; ++a)
#pragma unroll
        for (int b = 0; b < 2; ++b)
#pragma unroll
            for (int m = 0; m < 4; ++m)
#pragma unroll
                for (int n = 0; n < 2; ++n) acc[a][b][m][n] = (f32x4){0.f, 0.f, 0.f, 0.f};
    bf16x8 At[4][2], B0[2][2], B1[2][2];
    const char* cA = (const char*)g.A + (size_t)cur.pm * tstep; const char* cB = (const char*)g.Bt + (size_t)cur.pn * tstep;
    S.a_ready(cur);
    if constexpr (SP2) {
        PG8_STAGE(PG8_SB(0, 0), cB, voffB); PG8_STAGE(PG8_SB(0, 1), cB + hstep, voffB); PG8_STAGE(PG8_SA(0, 0), cA, voffA); PG8_STAGE(PG8_SA(0, 1), cA + hstep, voffA);
        if (wr == 1) PG8_BAR;
        PG8_WAIT_V(2); PG8_BAR;
        PG8_STAGE(PG8_SB(1, 0), cB + kstep, voffB); PG8_STAGE(PG8_SA(1, 0), cA + kstep, voffA); PG8_STAGE(PG8_SB(1, 1), cB + hstep + kstep, voffB);
        PG8_WAIT_V(6); PG8_BAR;
    } else {
        PG8_STAGE(PG8_SB(0, 0), cB, voffB); PG8_STAGE(PG8_SA(0, 0), cA, voffA); PG8_STAGE(PG8_SB(0, 1), cB + hstep, voffB); PG8_STAGE(PG8_SA(0, 1), cA + hstep, voffA);
        if (wr == 1) PG8_BAR;
        PG8_WAIT_V(4); PG8_BAR;
        PG8_STAGE(PG8_SB(1, 0), cB + kstep, voffB); PG8_STAGE(PG8_SA(1, 0), cA + kstep, voffA); PG8_STAGE(PG8_SB(1, 1), cB + hstep + kstep, voffB);
        PG8_WAIT_V(6); PG8_BAR;
    }
    for (;;) {
        const bool has_next = S.next(ui + 1, nxt);
        const char* nA = has_next ? (const char*)g.A + (size_t)nxt.pm * tstep : cA; const char* nB = has_next ? (const char*)g.Bt + (size_t)nxt.pn * tstep : cB;
        for (int t = 0; t < nt; t += 2) {
            const bool last = (t == nt - 2);
            const char* a1 = cA + (size_t)(t + 1) * kstep;
            const char* a2 = last ? nA : cA + (size_t)(t + 2) * kstep; const char* b2 = last ? nB : cB + (size_t)(t + 2) * kstep;
            const char* a3 = a2 + kstep; const char* b3 = b2 + kstep;
            if (last && has_next) S.a_ready(nxt);
            if constexpr (SP2) {
            PG8_LDB(B0, 0, 0); PG8_LDB(B1, 0, 1); PG8_SCHED; PG8_LDA(At, 0, 0); PG8_STAGE(PG8_SA(1, 1), a1 + hstep, voffA);
            PG8_WAIT_V(8); PG8_WAIT_L(0); PG8_BAR; PG8_MMA(0, 0, At, B0); PG8_MMA(0, 1, At, B1); PG8_BAR; PG8_SCHED;
            PG8_LDA(At, 0, 1); PG8_STAGE(PG8_SB(0, 0), b2, voffB); PG8_STAGE(PG8_SB(0, 1), b2 + hstep, voffB); PG8_STAGE(PG8_SA(0, 0), a2, voffA);
            PG8_WAIT_V(8); PG8_WAIT_L(0); PG8_BAR; PG8_MMA(1, 0, At, B0); PG8_MMA(1, 1, At, B1); PG8_BAR; PG8_SCHED;
            PG8_LDB(B0, 1, 0); PG8_LDB(B1, 1, 1); PG8_SCHED; PG8_LDA(At, 1, 0); PG8_STAGE(PG8_SA(0, 1), a2 + hstep, voffA);
            PG8_WAIT_V(8); PG8_WAIT_L(0); PG8_BAR; PG8_MMA(0, 0, At, B0); PG8_MMA(0, 1, At, B1); PG8_BAR; PG8_SCHED;
            PG8_LDA(At, 1, 1); PG8_STAGE(PG8_SB(1, 0), b3, voffB); PG8_STAGE(PG8_SB(1, 1), b3 + hstep, voffB); PG8_STAGE(PG8_SA(1, 0), a3, voffA);
            PG8_WAIT_V(8); PG8_WAIT_L(0); PG8_BAR; PG8_MMA(1, 0, At, B0); PG8_MMA(1, 1, At, B1); PG8_BAR; PG8_SCHED;
            } else {
            PG8_LDB(B0, 0, 0); PG8_SCHED; PG8_LDA(At, 0, 0); PG8_STAGE(PG8_SA(1, 1), a1 + hstep, voffA);
            PG8_WAIT_L(8); PG8_BAR; PG8_WAIT_L(0); PG8_MMA(0, 0, At, B0); PG8_BAR; PG8_SCHED;
            PG8_LDB(B1, 0, 1); PG8_STAGE(PG8_SB(0, 0), b2, voffB);
            PG8_BAR; PG8_WAIT_L(0); PG8_MMA(0, 1, At, B1); PG8_BAR;
            PG8_LDA(At, 0, 1); PG8_STAGE(PG8_SA(0, 0), a2, voffA);
            PG8_BAR; PG8_WAIT_L(0); PG8_MMA(1, 0, At, B0); PG8_BAR; PG8_SCHED;
            PG8_STAGE(PG8_SB(0, 1), b2 + hstep, voffB);
            PG8_WAIT_V(6); PG8_BAR; PG8_MMA(1, 1, At, B1); PG8_BAR;
            PG8_LDB(B0, 1, 0); PG8_SCHED; PG8_LDA(At, 1, 0); PG8_STAGE(PG8_SA(0, 1), a2 + hstep, voffA);
            PG8_WAIT_L(8); PG8_BAR; PG8_WAIT_L(0); PG8_MMA(0, 0, At, B0); PG8_BAR; PG8_SCHED;
            PG8_LDB(B1, 1, 1); PG8_STAGE(PG8_SB(1, 0), b3, voffB);
            PG8_BAR; PG8_WAIT_L(0); PG8_MMA(0, 1, At, B1); PG8_BAR;
            PG8_LDA(At, 1, 1); PG8_STAGE(PG8_SA(1, 0), a3, voffA);
            PG8_BAR; PG8_WAIT_L(0); PG8_MMA(1, 0, At, B0); PG8_BAR; PG8_SCHED;
            PG8_STAGE(PG8_SB(1, 1), b3 + hstep, voffB);
            PG8_WAIT_V(6); PG8_BAR; PG8_MMA(1, 1, At, B1); PG8_BAR;
            }
        }
        if constexpr (ALIGN_EPI) { if (wr == 0) PG8_BAR; }
        if constexpr (!Epi::AFTER_DRAIN) { E(acc, cur, wr, wc, fr, fq); S.done(cur); }
        if (!has_next) break;
#pragma unroll
        for (int a = 0; a < 2; ++a)
#pragma unroll
            for (int b = 0; b < 2; ++b)
#pragma unroll
                for (int m = 0; m < 4; ++m)
#pragma unroll
                    for (int n = 0; n < 2; ++n) acc[a][b][m][n] = (f32x4){0.f, 0.f, 0.f, 0.f};
        cur = nxt; cA = nA; cB = nB; ++ui;
        if constexpr (ALIGN_EPI) { if (wr == 1) PG8_BAR; }
    }
    PG8_WAIT_V(0);
    if constexpr (!ALIGN_EPI) { if (wr == 0) PG8_BAR; }
    PG8_BAR;
    if constexpr (Epi::AFTER_DRAIN) { E.fused(acc, cur, wr, wc, fr, fq, lds, wid, lane); S.done(cur); }
#undef PG8_SA
#undef PG8_SB
#undef PG8_STAGE
#undef PG8_LDA
#undef PG8_LDB
#undef PG8_MMA
#undef PG8_WAIT_V
#undef PG8_WAIT_L
#undef PG8_BAR
#undef PG8_SCHED
}
}

#define LAS __attribute__((address_space(3)))
typedef unsigned short bf16;
typedef short bf16x8 __attribute__((ext_vector_type(8)));
typedef short s16x4 __attribute__((ext_vector_type(4)));
typedef float f32x4 __attribute__((ext_vector_type(4)));
typedef float f32x16 __attribute__((ext_vector_type(16)));
typedef unsigned u32x4 __attribute__((ext_vector_type(4)));
typedef unsigned u32x2 __attribute__((ext_vector_type(2)));

constexpr int D_MODEL = 1024, NPROMPT = 32768, NSAMPLE = 512, MROWS = NPROMPT + NSAMPLE;
constexpr int SEQ = 8192, IN_W = 1792, D_FF = 2816;
constexpr float EPS = 1e-6f, LOG2E = 1.4426950408889634f, QSCALE = 0.125f * LOG2E;
constexpr size_t O_YP = 0, O_YS = 33554432, O_KP = 34078720, O_VP = 34144256, O_CP = 34209792, O_HP = 34215936, O_KS = 34217984, O_VS = 36315136, O_CS = 38412288, O_HS = 38608896;
constexpr size_t MiB = 1u << 20;
constexpr size_t WS_WIN = 1 * MiB, WS_WOUT = 5 * MiB, WS_WFI = 7 * MiB, WS_WFO = 18 * MiB, WS_WA = 24 * MiB, WS_WI = 24 * MiB + 65536;
constexpr size_t WS_SUMA = 25 * MiB, WS_SUMB = 26 * MiB, WS_SS2 = 27 * MiB, WS_SS3 = 30 * MiB, WS_HB = 33 * MiB;
constexpr size_t WS_XN = 98 * MiB, WS_Q = 163 * MiB, WS_K = 196 * MiB, WS_V = 205 * MiB, WS_XB = 214 * MiB, WS_GY = 247 * MiB, WS_MIX = 280 * MiB, WS_ACT = 98 * MiB, WS_END = 345 * MiB;
constexpr int LDS_BYTES = 147456;

struct Params { const float* in[23]; float* out; unsigned char* ws; int ph_lo, ph_hi; };

__device__ __forceinline__ unsigned pk2(float lo, float hi) {
    typedef __bf16 bf2 __attribute__((ext_vector_type(2)));
    bf2 v; v.x = (__bf16)lo; v.y = (__bf16)hi; return __builtin_bit_cast(unsigned, v);
}
__device__ __forceinline__ unsigned short f2bf(float f) { return (unsigned short)(pk2(f, 0.f) & 0xffffu); }
__device__ __forceinline__ float bf2f(unsigned short b) { return __uint_as_float((unsigned)b << 16); }
__device__ __forceinline__ void store8(bf16* dst, f32x4 a, f32x4 b) {
    u32x4 w; w.x = pk2(a[0], a[1]); w.y = pk2(a[2], a[3]); w.z = pk2(b[0], b[1]); w.w = pk2(b[2], b[3]); *(u32x4*)dst = w;
}
__device__ __forceinline__ float fast_sigmoid(float x) { return __builtin_amdgcn_rcpf(1.0f + __expf(-x)); }
__device__ __forceinline__ float gelu_tanh(float x) { const float u = 0.7978845608028654f * (x + 0.044715f * x * x * x); return x * __builtin_amdgcn_rcpf(1.0f + __expf(-2.0f * u)); }
__device__ __forceinline__ float wave_sum(float v) {
#pragma unroll
    for (int o = 1; o < 64; o <<= 1) v += __shfl_xor(v, o);
    return v;
}
__device__ __forceinline__ float wave_max(float v) {
#pragma unroll
    for (int o = 1; o < 64; o <<= 1) v = fmaxf(v, __shfl_xor(v, o));
    return v;
}

using pg8::Unit;
struct Epi1 {
    static constexpr bool PERM = true, AFTER_DRAIN = false;
    const float* bias; bf16 *Q, *Kb, *Vb, *XB, *GY; float* out;
    __device__ __forceinline__ void operator()(const f32x4 (&acc)[2][2][4][2], const Unit& u, int wr, int wc, int fr, int fq) const {
        const int pn = u.pn;
#pragma unroll
        for (int bj = 0; bj < 2; ++bj) {
            const int gcol = pn * 256 + bj * 128 + wc * 32 + fq * 8;
            const f32x4 b0 = *(const f32x4*)(bias + gcol), b1 = *(const f32x4*)(bias + gcol + 4);
#pragma unroll
            for (int ai = 0; ai < 2; ++ai)
#pragma unroll
                for (int m = 0; m < 4; ++m) {
                    const int row = u.pm * 256 + ai * 128 + wr * 64 + m * 16 + fr;
                    f32x4 v0 = acc[ai][bj][m][0] + b0, v1 = acc[ai][bj][m][1] + b1;
                    if (pn < 2) {
                        store8(Q + (size_t)row * 512 + gcol, v0 * QSCALE, v1 * QSCALE);
                    } else if (pn == 2) {
                        const int c = wc * 32 + fq * 8;
                        store8((bj == 0 ? Kb : Vb) + (size_t)row * 128 + c, v0, v1);
                        float* o = nullptr;
                        if (row < NPROMPT) { const int t = row & 8191; if (t >= 8064) o = out + (bj == 0 ? O_KP : O_VP) + ((size_t)((row >> 13) * 128 + (t - 8064)) * 128 + c); }
                        else { const int r = row - NPROMPT; o = out + (bj == 0 ? O_KS : O_VS) + ((size_t)((r >> 2) * 128 + 124 + (r & 3)) * 128 + c); }
                        if (o) { *(f32x4*)o = v0; *(f32x4*)(o + 4) = v1; }
                    } else if (pn < 5) {
                        const int c = gcol - 768;
                        store8(XB + (size_t)row * 512 + c, v0, v1);
                        float* o = nullptr;
                        if (row < NPROMPT) { const int t = row & 8191; if (t >= 8189) o = out + O_CP + ((size_t)((row >> 13) * 3 + (t - 8189)) * 512 + c); }
                        else { const int r = row - NPROMPT, i = r & 3; if (i >= 1) o = out + O_CS + ((size_t)((r >> 2) * 3 + (i - 1)) * 512 + c); }
                        if (o) { *(f32x4*)o = v0; *(f32x4*)(o + 4) = v1; }
                    } else {
                        const int c = gcol - 1280;
#pragma unroll
                        for (int j = 0; j < 4; ++j) { v0[j] = gelu_tanh(v0[j]); v1[j] = gelu_tanh(v1[j]); }
                        store8(GY + (size_t)row * 512 + c, v0, v1);
                    }
                }
        }
    }
};
struct Epi2 {
    static constexpr bool PERM = false, AFTER_DRAIN = false;
    const float *xp, *xs, *bias; float* out; bf16* Hb; float* SS;
    __device__ __forceinline__ void operator()(const f32x4 (&acc)[2][2][4][2], const Unit& u, int wr, int wc, int fr, int fq) const {
        const int col0 = u.pn * 256 + wc * 32 + 4 * fq;
        f32x4 bv[2][2];
#pragma unroll
        for (int bj = 0; bj < 2; ++bj)
#pragma unroll
            for (int n = 0; n < 2; ++n) bv[bj][n] = *(const f32x4*)(bias + col0 + bj * 128 + n * 16);
#pragma unroll
        for (int ai = 0; ai < 2; ++ai)
#pragma unroll
            for (int m = 0; m < 4; ++m) {
                const int row = u.pm * 256 + ai * 128 + wr * 64 + m * 16 + fr;
                const float* xrow = row < NPROMPT ? xp + (size_t)row * 1024 : xs + (size_t)(row - NPROMPT) * 1024;
                float s = 0.f;
#pragma unroll
                for (int bj = 0; bj < 2; ++bj)
#pragma unroll
                    for (int n = 0; n < 2; ++n) {
                        const int c = col0 + bj * 128 + n * 16;
                        const f32x4 hv = acc[ai][bj][m][n] + bv[bj][n] + *(const f32x4*)(xrow + c);
                        u32x2 w; w.x = pk2(hv[0], hv[1]); w.y = pk2(hv[2], hv[3]); *(u32x2*)(Hb + (size_t)row * 1024 + c) = w;
                        s += (hv[0] * hv[0] + hv[1] * hv[1]) + (hv[2] * hv[2] + hv[3] * hv[3]);
                    }
                s += __shfl_xor(s, 16); s += __shfl_xor(s, 32);
                if (fq == 0) SS[(size_t)row * 16 + u.pn * 4 + wc] = s;
            }
    }
};
struct Epi3 {
    static constexpr bool PERM = true, AFTER_DRAIN = false;
    const float* SS; bf16* ACT;
    __device__ __forceinline__ void operator()(const f32x4 (&acc)[2][2][4][2], const Unit& u, int wr, int wc, int fr, int fq) const {
        const int j0 = u.pn * 128 + wc * 32 + fq * 8;
#pragma unroll
        for (int ai = 0; ai < 2; ++ai)
#pragma unroll
            for (int m = 0; m < 4; ++m) {
                const int row = u.pm * 256 + ai * 128 + wr * 64 + m * 16 + fr;
                const f32x4* sp = (const f32x4*)(SS + (size_t)row * 16);
                const f32x4 s0 = sp[0], s1 = sp[1], s2 = sp[2], s3 = sp[3];
                const float ss = ((s0[0] + s0[1]) + (s0[2] + s0[3])) + ((s1[0] + s1[1]) + (s1[2] + s1[3])) + ((s2[0] + s2[1]) + (s2[2] + s2[3])) + ((s3[0] + s3[1]) + (s3[2] + s3[3]));
                const float rstd = __builtin_amdgcn_rsqf(ss * (1.0f / 1024.0f) + EPS);
                f32x4 a[2];
#pragma unroll
                for (int n = 0; n < 2; ++n) {
                    const f32x4 g = acc[ai][0][m][n] * rstd, up = acc[ai][1][m][n] * rstd;
#pragma unroll
                    for (int j = 0; j < 4; ++j) a[n][j] = g[j] * fast_sigmoid(g[j]) * up[j];
                }
                store8(ACT + (size_t)row * D_FF + j0, a[0], a[1]);
            }
    }
};
struct Epi4 {
    static constexpr bool PERM = false, AFTER_DRAIN = false;
    float* out; const bf16* Hb; float* SS;
    __device__ __forceinline__ void operator()(const f32x4 (&acc)[2][2][4][2], const Unit& u, int wr, int wc, int fr, int fq) const {
        const int col0 = u.pn * 256 + wc * 32 + 4 * fq;
#pragma unroll
        for (int ai = 0; ai < 2; ++ai)
#pragma unroll
            for (int m = 0; m < 4; ++m) {
                const int row = u.pm * 256 + ai * 128 + wr * 64 + m * 16 + fr;
                float s = 0.f;
#pragma unroll
                for (int bj = 0; bj < 2; ++bj)
#pragma unroll
                    for (int n = 0; n < 2; ++n) {
                        const size_t off = (size_t)row * 1024 + col0 + bj * 128 + n * 16;
                        const u32x2 hw = *(const u32x2*)(Hb + off);
                        f32x4 y; y[0] = __uint_as_float(hw.x << 16); y[1] = __uint_as_float(hw.x & 0xffff0000u); y[2] = __uint_as_float(hw.y << 16); y[3] = __uint_as_float(hw.y & 0xffff0000u);
                        y += acc[ai][bj][m][n];
                        *(f32x4*)(out + off) = y;
                        s += (y[0] * y[0] + y[1] * y[1]) + (y[2] * y[2] + y[3] * y[3]);
                    }
                s += __shfl_xor(s, 16); s += __shfl_xor(s, 32);
                if (fq == 0) SS[(size_t)row * 16 + u.pn * 4 + wc] = s;
            }
    }
};

#ifndef DUP_PH
#define DUP_PH -1
#endif
template <bool DUP> struct ProbeOrder : pg8::StaticOrder {
    __device__ bool next(int i, Unit& u) const {
        if (!DUP) return pg8::StaticOrder::next(i, u);
        const int R = c < nwg ? (nwg - c + G - 1) / G : 0;
        return i < 2 * R && pg8::StaticOrder::next(i < R ? i : i - R, u);
    }
};
__device__ __forceinline__ void transpose_item(const float* W, int K, int ldw, bf16* WT, int kb, int dst_n0, int src_n0, const float* g, LAS float* scr, int lane) {
    const int k0 = 64 * kb;
#pragma unroll 8
    for (int i = 0; i < 32; ++i) { const int kk = 2 * i + (lane >> 5); float v = W[(size_t)(k0 + kk) * ldw + src_n0 + (lane & 31)]; if (g) v *= g[k0 + kk]; scr[kk * 33 + (lane & 31)] = v; }
    asm volatile("s_waitcnt lgkmcnt(0)" ::: "memory");
    const int c = lane & 7;
#pragma unroll
    for (int j = 0; j < 4; ++j) { const int n = (lane >> 3) + 8 * j; const LAS float* s = scr + (8 * c) * 33 + n;
        u32x4 o; o.x = pk2(s[0 * 33], s[1 * 33]); o.y = pk2(s[2 * 33], s[3 * 33]); o.z = pk2(s[4 * 33], s[5 * 33]); o.w = pk2(s[6 * 33], s[7 * 33]);
        *(u32x4*)(WT + (size_t)(dst_n0 + n) * K + k0 + 8 * c) = o; }
    asm volatile("s_waitcnt lgkmcnt(0)" ::: "memory");
}
__device__ __forceinline__ void p0_prologue(const Params& p, LAS unsigned char* lds, int tid, int wave, int lane) {
    unsigned char* ws = p.ws;
    LAS float* scr = (LAS float*)(lds + wave * 16384);
    const int gw = blockIdx.x * 8 + wave, NGW = gridDim.x * 8;
    constexpr int I_IN = 16 * 56, I_OUT = 16 * 32, I_FI = 16 * 176, I_FO = 44 * 32, NITEMS = I_IN + I_OUT + I_FI + I_FO;
    for (int it = gw; it < NITEMS; it += NGW) {
        int r = it;
        if (r < I_IN) { const int kb = r / 56, nb = r % 56; transpose_item(p.in[7], 1024, IN_W, (bf16*)(ws + WS_WIN), kb, 32 * nb, 32 * nb, nullptr, scr, lane); continue; } r -= I_IN;
        if (r < I_OUT) { const int kb = r / 32, nb = r % 32; transpose_item(p.in[17], 1024, 1024, (bf16*)(ws + WS_WOUT), kb, 32 * nb, 32 * nb, nullptr, scr, lane); continue; } r -= I_OUT;
        if (r < I_FI) { const int kb = r / 176, nb = r % 176; const int d0 = 32 * nb, pn = d0 >> 8, bj = (d0 >> 7) & 1, i0 = d0 & 127;
            transpose_item(p.in[20], 1024, 2 * D_FF, (bf16*)(ws + WS_WFI), kb, d0, bj * D_FF + 128 * pn + i0, p.in[19], scr, lane); continue; } r -= I_FI;
        { const int kb = r / 32, nb = r % 32; transpose_item(p.in[21], D_FF, 1024, (bf16*)(ws + WS_WFO), kb, 32 * nb, 32 * nb, nullptr, scr, lane); }
    }
    const int gt = blockIdx.x * 512 + tid, NGT = gridDim.x * 512;
    for (int idx = gt; idx < 2 * 32768; idx += NGT) {
        const int which = idx >> 15, r = idx & 32767, n = r >> 12, e = (r >> 6) & 63, d = r & 63;
        const float v = (which ? p.in[14] : p.in[12])[n * 4096 + d * 64 + e];
        ((bf16*)(ws + (which ? WS_WI : WS_WA)))[r] = f2bf(v);
    }
    for (int idx = gt; idx < 2 * 128 * 3968; idx += NGT) {
        const int which = idx / (128 * 3968), r = idx % (128 * 3968), sb = r / 3968, e = r % 3968;
        const f32x4 v = *(const f32x4*)((which ? p.in[3] : p.in[2]) + (size_t)sb * 16384 + 512 + 4 * e);
        *(f32x4*)(p.out + (which ? O_VS : O_KS) + (size_t)sb * 16384 + 4 * e) = v;
    }
    const float* gm = p.in[6];
    f32x4 gv[4];
#pragma unroll
    for (int j = 0; j < 4; ++j) gv[j] = *(const f32x4*)(gm + 256 * j + 4 * lane);
    bf16* XN = (bf16*)(ws + WS_XN);
    for (int row = gw; row < MROWS; row += NGW) {
        const float* xr = row < NPROMPT ? p.in[0] + (size_t)row * 1024 : p.in[1] + (size_t)(row - NPROMPT) * 1024;
        f32x4 v[4]; float s = 0.f;
#pragma unroll
        for (int j = 0; j < 4; ++j) { v[j] = *(const f32x4*)(xr + 256 * j + 4 * lane); s += (v[j][0] * v[j][0] + v[j][1] * v[j][1]) + (v[j][2] * v[j][2] + v[j][3] * v[j][3]); }
        const float rstd = __builtin_amdgcn_rsqf(wave_sum(s) * (1.0f / 1024.0f) + EPS);
#pragma unroll
        for (int j = 0; j < 4; ++j) { const f32x4 o = v[j] * rstd * gv[j]; u32x2 w; w.x = pk2(o[0], o[1]); w.y = pk2(o[2], o[3]); *(u32x2*)(XN + (size_t)row * 1024 + 256 * j + 4 * lane) = w; }
    }
}

__device__ __forceinline__ void attn_prompt_unit(const Params& p, LAS unsigned char* lds, int unit, int tid, int wave, int lane) {
    const int kvh = unit & 1, nb = (unit >> 1) & 63, b = unit >> 7;
    const bf16* Qb = (const bf16*)(p.ws + WS_Q); const bf16* Kb = (const bf16*)(p.ws + WS_K); const bf16* Vb = (const bf16*)(p.ws + WS_V); bf16* MIX = (bf16*)(p.ws + WS_MIX);
    LAS unsigned char* Ks = lds; LAS unsigned char* Vs = lds + 36864;
    const int rowbase = b * SEQ + nb * 128;
#pragma unroll
    for (int i = 0; i < 4; ++i) {
        const int idx = tid + 512 * i, jr = idx >> 3, ck = idx & 7; const int grow = rowbase - 128 + jr;
        u32x4 kv = {0u, 0u, 0u, 0u}, vv = {0u, 0u, 0u, 0u};
        if (nb > 0 || jr >= 128) { kv = *(const u32x4*)(Kb + (size_t)grow * 128 + kvh * 64 + ck * 8); vv = *(const u32x4*)(Vb + (size_t)grow * 128 + kvh * 64 + ck * 8); }
        *(LAS u32x4*)(Ks + jr * 144 + ck * 16) = kv; *(LAS u32x4*)(Vs + jr * 192 + ck * 16) = vv;
    }
    __syncthreads();
    const int g = wave & 3, hh = kvh * 4 + g, c = lane & 31, h = lane >> 5;
    const float slope2 = exp2f(-(float)(hh + 1)) * LOG2E, sink2 = p.in[9][hh] * LOG2E;
#pragma unroll 1
    for (int ci = 0; ci < 2; ++ci) {
        const int r0 = 32 * ((wave >> 2) * 2 + ci);
        bf16x8 qf[4];
#pragma unroll
        for (int s = 0; s < 4; ++s) qf[s] = *(const bf16x8*)(Qb + (size_t)(rowbase + r0 + c) * 512 + hh * 64 + 16 * s + 8 * h);
        f32x16 S[5];
#pragma unroll
        for (int kt = 0; kt < 5; ++kt) {
#pragma unroll
            for (int r = 0; r < 16; ++r) S[kt][r] = 0.f;
#pragma unroll
            for (int s = 0; s < 4; ++s) { const bf16x8 kf = *(const LAS bf16x8*)(Ks + (r0 + 32 * kt + c) * 144 + (16 * s + 8 * h) * 2); S[kt] = __builtin_amdgcn_mfma_f32_32x32x16_bf16(kf, qf[s], S[kt], 0, 0, 0); }
        }
        float m = sink2;
        int base = 128 + c - 4 * h;
        asm volatile("" : "+v"(base));
        const float t0 = -slope2 * (float)base;
#pragma unroll
        for (int kt = 0; kt < 5; ++kt)
#pragma unroll
            for (int r = 0; r < 16; ++r) {
                const int K = 32 * kt + (r & 3) + 8 * (r >> 2);
                float sv = __builtin_fmaf(slope2, (float)K, S[kt][r] + t0);
                if (kt == 0) sv = (base - K < 128) ? sv : -1e30f;
                if (kt == 4) sv = (base - K >= 0) ? sv : -1e30f;
                S[kt][r] = sv;
            }
        if (nb == 0) {
#pragma unroll
            for (int kt = 0; kt < 5; ++kt)
#pragma unroll
                for (int r = 0; r < 16; ++r) { const int K = 32 * kt + (r & 3) + 8 * (r >> 2); if (r0 + 4 * h + K < 128) S[kt][r] = -1e30f; }
        }
#pragma unroll
        for (int kt = 0; kt < 5; ++kt)
#pragma unroll
            for (int r = 0; r < 16; ++r) m = fmaxf(m, S[kt][r]);
        m = fmaxf(m, __shfl_xor(m, 32));
        float l = 0.f;
#pragma unroll
        for (int kt = 0; kt < 5; ++kt)
#pragma unroll
            for (int r = 0; r < 16; ++r) { const float pv = __builtin_amdgcn_exp2f(S[kt][r] - m); S[kt][r] = pv; l += pv; }
        l += __shfl_xor(l, 32); l += __builtin_amdgcn_exp2f(sink2 - m);
        const float inv = 1.0f / l;
        f32x16 O0, O1;
#pragma unroll
        for (int r = 0; r < 16; ++r) { O0[r] = 0.f; O1[r] = 0.f; }
        const int vlane = ((lane & 15) >> 2) * 192 + (16 * ((lane >> 4) & 1) + 4 * (lane & 3)) * 2 + 4 * h * 192;
#pragma unroll
        for (int kt = 0; kt < 5; ++kt)
#pragma unroll
            for (int s = 0; s < 2; ++s) {
                u32x4 pw;
                pw.x = pk2(S[kt][8 * s + 0] * inv, S[kt][8 * s + 1] * inv); pw.y = pk2(S[kt][8 * s + 2] * inv, S[kt][8 * s + 3] * inv);
                pw.z = pk2(S[kt][8 * s + 4] * inv, S[kt][8 * s + 5] * inv); pw.w = pk2(S[kt][8 * s + 6] * inv, S[kt][8 * s + 7] * inv);
                const bf16x8 pa = __builtin_bit_cast(bf16x8, pw);
                const int kb = r0 + 32 * kt + 16 * s;
#pragma unroll
                for (int nt = 0; nt < 2; ++nt) {
                    const s16x4 v0 = __builtin_amdgcn_ds_read_tr16_b64_v4i16((LAS s16x4*)(Vs + kb * 192 + vlane + nt * 64));
                    const s16x4 v1 = __builtin_amdgcn_ds_read_tr16_b64_v4i16((LAS s16x4*)(Vs + (kb + 8) * 192 + vlane + nt * 64));
                    bf16x8 vb; vb[0] = v0[0]; vb[1] = v0[1]; vb[2] = v0[2]; vb[3] = v0[3]; vb[4] = v1[0]; vb[5] = v1[1]; vb[6] = v1[2]; vb[7] = v1[3];
                    if (nt == 0) O0 = __builtin_amdgcn_mfma_f32_32x32x16_bf16(pa, vb, O0, 0, 0, 0); else O1 = __builtin_amdgcn_mfma_f32_32x32x16_bf16(pa, vb, O1, 0, 0, 0);
                }
                asm volatile("" ::: "memory");
            }
#pragma unroll
        for (int r = 0; r < 16; ++r) {
            const int qrow = r0 + (r & 3) + 8 * (r >> 2) + 4 * h;
            bf16* o = MIX + (size_t)(rowbase + qrow) * 1024 + hh * 64 + c;
            o[0] = f2bf(O0[r]); o[32] = f2bf(O1[r]);
        }
    }
    __syncthreads();
}

__device__ __forceinline__ void attn_sample_unit(const Params& p, LAS unsigned char* lds, int unit, int tid, int wave, int lane) {
    const int kvh = unit & 1, sb = unit >> 1;
    const bf16* Qb = (const bf16*)(p.ws + WS_Q); bf16* MIX = (bf16*)(p.ws + WS_MIX);
    LAS float* Kf = (LAS float*)lds; LAS float* Vf = Kf + 132 * 65; LAS float* Qf = Vf + 132 * 64; LAS float* Pf = Qf + 1024;
    for (int i = 0; i < 17; ++i) {
        const int idx = tid + 512 * i;
        if (idx < 132 * 64) {
            const int j = idx >> 6, d = idx & 63; float kv, vv;
            if (j < 4) { const size_t o = ((size_t)(sb * 128 + j) * 2 + kvh) * 64 + d; kv = p.in[2][o]; vv = p.in[3][o]; }
            else { const size_t o = (size_t)(sb * 128 + j - 4) * 128 + kvh * 64 + d; kv = p.out[O_KS + o]; vv = p.out[O_VS + o]; }
            Kf[j * 65 + d] = kv; Vf[j * 64 + d] = vv;
        }
    }
#pragma unroll
    for (int i = 0; i < 2; ++i) { const int idx = tid + 512 * i, rr = idx >> 6, d = idx & 63;
        Qf[idx] = bf2f(Qb[(size_t)(NPROMPT + sb * 4 + (rr & 3)) * 512 + (kvh * 4 + (rr >> 2)) * 64 + d]); }
    __syncthreads();
#pragma unroll 1
    for (int r2 = 0; r2 < 2; ++r2) {
        const int rr = wave * 2 + r2, g = rr >> 2, it = rr & 3, hh = kvh * 4 + g;
        const float slope2 = exp2f(-(float)(hh + 1)) * LOG2E, sink2 = p.in[9][hh] * LOG2E;
        float sc[3]; float m = sink2;
#pragma unroll
        for (int kk = 0; kk < 3; ++kk) {
            const int j = lane + 64 * kk, jj = j < 132 ? j : 131; float s = 0.f;
#pragma unroll 8
            for (int d = 0; d < 64; ++d) s += Qf[rr * 64 + d] * Kf[jj * 65 + d];
            const int dist = 128 + it - j; const bool valid = (j < 132) && (dist >= 0) && (dist < 128);
            sc[kk] = valid ? s - slope2 * (float)dist : -1e30f; m = fmaxf(m, sc[kk]);
        }
        m = wave_max(m);
        float l = 0.f;
#pragma unroll
        for (int kk = 0; kk < 3; ++kk) { sc[kk] = __builtin_amdgcn_exp2f(sc[kk] - m); l += sc[kk]; }
        l = wave_sum(l) + __builtin_amdgcn_exp2f(sink2 - m);
        const float inv = 1.0f / l;
#pragma unroll
        for (int kk = 0; kk < 3; ++kk) { const int j = lane + 64 * kk; if (j < 132) Pf[wave * 136 + j] = sc[kk] * inv; }
        __syncthreads();
        float o = 0.f;
#pragma unroll 4
        for (int j = 0; j < 132; ++j) o += Pf[wave * 136 + j] * Vf[j * 64 + lane];
        MIX[(size_t)(NPROMPT + sb * 4 + it) * 1024 + hh * 64 + lane] = f2bf(o);
        __syncthreads();
    }
}

template <int MODE>
__device__ __forceinline__ void lru_unit(const Params& p, LAS unsigned char* lds, int unit, int wave, int lane) {
    const int n = wave, cp = lane & 31, th = lane >> 5, c = lane & 31, h = lane >> 5;
    LAS unsigned char* xcs = lds + wave * 9216;
    const bf16* XB = (const bf16*)(p.ws + WS_XB); const bf16* GY = (const bf16*)(p.ws + WS_GY); bf16* MIX = (bf16*)(p.ws + WS_MIX);
    const bf16* WA = (const bf16*)(p.ws + WS_WA); const bf16* WI = (const bf16*)(p.ws + WS_WI);
    float* SUMA = (float*)(p.ws + WS_SUMA); float* SUMB = (float*)(p.ws + WS_SUMB);
    const int b = unit >> 7, chunk = unit & 127;
    const int rowbase = MODE < 2 ? b * SEQ + chunk * 64 : NPROMPT + unit * 32;
    {
        const int ch2 = n * 64 + 2 * cp;
        const float* cw = p.in[10]; const float* cb = p.in[11];
        const float w0a = cw[ch2], w0b = cw[ch2 + 1], w1a = cw[512 + ch2], w1b = cw[512 + ch2 + 1], w2a = cw[1024 + ch2], w2b = cw[1024 + ch2 + 1], w3a = cw[1536 + ch2], w3b = cw[1536 + ch2 + 1];
        const float bia = cb[ch2], bib = cb[ch2 + 1];
        if (MODE < 2) {
            const int tl0 = th * 32;
            float xa[3], xb[3];
#pragma unroll
            for (int i = 0; i < 3; ++i) {
                const int tl = tl0 - 3 + i; unsigned v = 0u;
                if (chunk > 0 || tl >= 0) v = *(const unsigned*)(XB + (size_t)(rowbase + tl) * 512 + ch2);
                xa[i] = bf2f((unsigned short)(v & 0xffffu)); xb[i] = bf2f((unsigned short)(v >> 16));
            }
#pragma unroll
            for (int t = 0; t < 32; ++t) {
                const unsigned v = *(const unsigned*)(XB + (size_t)(rowbase + tl0 + t) * 512 + ch2);
                const float x3a = bf2f((unsigned short)(v & 0xffffu)), x3b = bf2f((unsigned short)(v >> 16));
                const float ya = bia + w0a * xa[0] + w1a * xa[1] + w2a * xa[2] + w3a * x3a, yb = bib + w0b * xb[0] + w1b * xb[1] + w2b * xb[2] + w3b * x3b;
                *(LAS unsigned*)(xcs + (tl0 + t) * 144 + cp * 4) = pk2(ya, yb);
                xa[0] = xa[1]; xa[1] = xa[2]; xa[2] = x3a; xb[0] = xb[1]; xb[1] = xb[2]; xb[2] = x3b;
            }
        } else {
            const float* sc = p.in[4];
#pragma unroll
            for (int q = 0; q < 4; ++q) {
                const int bi = th * 4 + q, sb = unit * 8 + bi;
                float ia[7], ib[7];
#pragma unroll
                for (int i = 0; i < 3; ++i) { ia[i] = sc[(size_t)(sb * 3 + i) * 512 + ch2]; ib[i] = sc[(size_t)(sb * 3 + i) * 512 + ch2 + 1]; }
#pragma unroll
                for (int i = 0; i < 4; ++i) { const unsigned v = *(const unsigned*)(XB + (size_t)(rowbase + bi * 4 + i) * 512 + ch2); ia[3 + i] = bf2f((unsigned short)(v & 0xffffu)); ib[3 + i] = bf2f((unsigned short)(v >> 16)); }
#pragma unroll
                for (int i = 0; i < 4; ++i) {
                    const float ya = bia + w0a * ia[i] + w1a * ia[i + 1] + w2a * ia[i + 2] + w3a * ia[i + 3], yb = bib + w0b * ib[i] + w1b * ib[i + 1] + w2b * ib[i + 2] + w3b * ib[i + 3];
                    *(LAS unsigned*)(xcs + (bi * 4 + i) * 144 + cp * 4) = pk2(ya, yb);
                }
            }
        }
    }
    float hin = 0.f;
    if (MODE == 1) {
        const float* sa = SUMA + (size_t)(b * 128) * 512 + n * 64 + lane; const float* sbp = SUMB + (size_t)(b * 128) * 512 + n * 64 + lane;
        int j = 0;
        for (; j + 8 <= chunk; j += 8) {
            float aa[8], bb[8];
#pragma unroll
            for (int q = 0; q < 8; ++q) { aa[q] = sa[(size_t)(j + q) * 512]; bb[q] = sbp[(size_t)(j + q) * 512]; }
#pragma unroll
            for (int q = 0; q < 8; ++q) hin = aa[q] * hin + bb[q];
        }
        for (; j < chunk; ++j) hin = sa[(size_t)j * 512] * hin + sbp[(size_t)j * 512];
    }
    __syncthreads();
#pragma unroll 1
    for (int et = 0; et < 2; ++et) {
        const int chl = et * 32 + c, ch = n * 64 + chl;
        const float ba = p.in[13][ch], bi_ = p.in[15][ch], lam = p.in[16][ch];
        const float sp8 = 8.0f * log1pf(__expf(-lam));
        bf16x8 wa[4], wi[4];
#pragma unroll
        for (int s = 0; s < 4; ++s) { wa[s] = *(const bf16x8*)(WA + (size_t)(n * 64 + chl) * 64 + 16 * s + 8 * h); wi[s] = *(const bf16x8*)(WI + (size_t)(n * 64 + chl) * 64 + 16 * s + 8 * h); }
        float hcar = MODE == 1 ? __shfl(hin, chl) : 0.f;
        float Atot = 1.f;
#pragma unroll 1
        for (int tt = 0; tt < (MODE == 2 ? 1 : 2); ++tt) {
            f32x16 accA, accI;
#pragma unroll
            for (int r = 0; r < 16; ++r) { accA[r] = 0.f; accI[r] = 0.f; }
#pragma unroll
            for (int s = 0; s < 4; ++s) {
                const bf16x8 af = *(const LAS bf16x8*)(xcs + (tt * 32 + c) * 144 + (16 * s + 8 * h) * 2);
                accA = __builtin_amdgcn_mfma_f32_32x32x16_bf16(af, wa[s], accA, 0, 0, 0);
                accI = __builtin_amdgcn_mfma_f32_32x32x16_bf16(af, wi[s], accI, 0, 0, 0);
            }
            float av[16], bv[16];
#pragma unroll
            for (int r = 0; r < 16; ++r) {
                const int tok = tt * 32 + (r & 3) + 8 * (r >> 2) + 4 * h;
                const float xcv = bf2f(*(const LAS unsigned short*)(xcs + tok * 144 + chl * 2));
                const float rg = fast_sigmoid(accA[r] + ba), ig = fast_sigmoid(accI[r] + bi_);
                const float a = __expf(-sp8 * rg);
                av[r] = a; bv[r] = sqrtf(fmaxf(1.0f - a * a, 0.f)) * ig * xcv;
            }
            if (MODE < 2) {
                float Ae[4], Be[4], Ao[4], Bo[4];
#pragma unroll
                for (int g = 0; g < 4; ++g) {
                    const float A = (av[4 * g] * av[4 * g + 1]) * (av[4 * g + 2] * av[4 * g + 3]);
                    const float B = ((bv[4 * g] * av[4 * g + 1] + bv[4 * g + 1]) * av[4 * g + 2] + bv[4 * g + 2]) * av[4 * g + 3] + bv[4 * g + 3];
                    const float pA = __shfl_xor(A, 32), pB = __shfl_xor(B, 32);
                    Ae[g] = h ? pA : A; Be[g] = h ? pB : B; Ao[g] = h ? A : pA; Bo[g] = h ? B : pB;
                }
                float hs[4]; float x = hcar;
#pragma unroll
                for (int g = 0; g < 4; ++g) { const float he = x; x = Ae[g] * x + Be[g]; const float ho = x; x = Ao[g] * x + Bo[g]; hs[g] = h ? ho : he; Atot *= Ae[g] * Ao[g]; }
                hcar = x;
                if (MODE == 1) {
#pragma unroll
                    for (int g = 0; g < 4; ++g) {
                        float y = hs[g];
#pragma unroll
                        for (int i = 0; i < 4; ++i) {
                            y = av[4 * g + i] * y + bv[4 * g + i];
                            const int row = rowbase + tt * 32 + 8 * g + 4 * h + i;
                            const float gy = bf2f(GY[(size_t)row * 512 + ch]);
                            MIX[(size_t)row * 1024 + 512 + ch] = f2bf(y * gy);
                        }
                    }
                }
            } else {
#pragma unroll
                for (int g = 0; g < 4; ++g) {
                    const int sb = unit * 8 + 2 * g + h;
                    float y = p.in[5][(size_t)sb * 512 + ch];
#pragma unroll
                    for (int i = 0; i < 4; ++i) {
                        y = av[4 * g + i] * y + bv[4 * g + i];
                        const int row = rowbase + 8 * g + 4 * h + i;
                        const float gy = bf2f(GY[(size_t)row * 512 + ch]);
                        MIX[(size_t)row * 1024 + 512 + ch] = f2bf(y * gy);
                    }
                    p.out[O_HS + (size_t)sb * 512 + ch] = y;
                }
            }
        }
        if (MODE == 0 && h == 0) { SUMA[(size_t)(b * 128 + chunk) * 512 + ch] = Atot; SUMB[(size_t)(b * 128 + chunk) * 512 + ch] = hcar; }
        if (MODE == 1 && chunk == 127 && h == 0) p.out[O_HP + (size_t)b * 512 + ch] = hcar;
    }
    __syncthreads();
}

__global__ void __launch_bounds__(512, 2) fwd(Params p) {
    extern __shared__ __attribute__((aligned(16))) unsigned char lds_raw[];
    LAS unsigned char* lds = (LAS unsigned char*)lds_raw;
    const int tid = threadIdx.x, lane = tid & 63, wave = __builtin_amdgcn_readfirstlane(tid >> 6);
    const int lo = p.ph_lo, hi = p.ph_hi, G = gridDim.x;
    unsigned char* ws = p.ws;
#ifdef ONLY_PH
#define IN_PH(k) ((k) == ONLY_PH)
#else
#define IN_PH(k) (lo <= (k) && (k) < hi)
#endif
#define REPS(k)
#define SEAM(k) do { if (lo <= (k) && (k) + 1 < hi) cg::this_grid().sync(); } while (0)

    if (IN_PH(0)) { p0_prologue(p, lds, tid, wave, lane); if (DUP_PH == 0) p0_prologue(p, lds, tid, wave, lane); }
    SEAM(0);
    if (IN_PH(1)) REPS(1) {
        pg8::Gemm g{(const bf16*)(ws + WS_XN), (const bf16*)(ws + WS_WIN), MROWS, IN_W, 1024}; ProbeOrder<DUP_PH == 1> S; S.init(MROWS, IN_W, G, (int)blockIdx.x);
        Epi1 E{p.in[8], (bf16*)(ws + WS_Q), (bf16*)(ws + WS_K), (bf16*)(ws + WS_V), (bf16*)(ws + WS_XB), (bf16*)(ws + WS_GY), p.out};
        pg8::gemm_phase<Epi1, ProbeOrder<DUP_PH == 1>, true, true>(lds, g, S, E);
    }
    SEAM(1);
    if (IN_PH(2)) {
#pragma unroll 1
        for (int u = blockIdx.x; u < (DUP_PH == 20 ? 1024 : 512); u += G) attn_prompt_unit(p, lds, u & 511, tid, wave, lane);
#pragma unroll 1
        for (int u = blockIdx.x; u < (DUP_PH == 21 ? 1024 : 512); u += G) lru_unit<0>(p, lds, u & 511, wave, lane);
#pragma unroll 1
        for (int u = blockIdx.x; u < (DUP_PH == 22 ? 512 : 256); u += G) attn_sample_unit(p, lds, u & 255, tid, wave, lane);
    }
    SEAM(2);
    if (IN_PH(3)) REPS(3) {
#pragma unroll 1
        for (int u = blockIdx.x; u < (DUP_PH == 3 ? 1024 : 512); u += G) lru_unit<1>(p, lds, u & 511, wave, lane);
#pragma unroll 1
        for (int u = blockIdx.x; u < 16; u += G) lru_unit<2>(p, lds, u, wave, lane);
    }
    SEAM(3);
    if (IN_PH(4)) REPS(4) {
        pg8::Gemm g{(const bf16*)(ws + WS_MIX), (const bf16*)(ws + WS_WOUT), MROWS, 1024, 1024}; ProbeOrder<DUP_PH == 4> S; S.init(MROWS, 1024, G, (int)blockIdx.x);
        Epi2 E{p.in[0], p.in[1], p.in[18], p.out, (bf16*)(ws + WS_HB), (float*)(ws + WS_SS2)};
        pg8::gemm_phase<Epi2, ProbeOrder<DUP_PH == 4>, true, true>(lds, g, S, E);
    }
    SEAM(4);
    if (IN_PH(5)) REPS(5) {
        pg8::Gemm g{(const bf16*)(ws + WS_HB), (const bf16*)(ws + WS_WFI), MROWS, 2 * D_FF, 1024}; ProbeOrder<DUP_PH == 5> S; S.init(MROWS, 2 * D_FF, G, (int)blockIdx.x);
        Epi3 E{(const float*)(ws + WS_SS2), (bf16*)(ws + WS_ACT)};
        pg8::gemm_phase<Epi3, ProbeOrder<DUP_PH == 5>, true, true>(lds, g, S, E);
    }
    SEAM(5);
    if (IN_PH(6)) {
        pg8::Gemm g{(const bf16*)(ws + WS_ACT), (const bf16*)(ws + WS_WFO), MROWS, 1024, D_FF}; ProbeOrder<DUP_PH == 6> S; S.init(MROWS, 1024, G, (int)blockIdx.x);
        Epi4 E{p.out, (const bf16*)(ws + WS_HB), (float*)(ws + WS_SS3)};
        pg8::gemm_phase<Epi4, ProbeOrder<DUP_PH == 6>, true, true>(lds, g, S, E);
    }
    SEAM(6);
    if (IN_PH(7)) {
        const float* gf = p.in[22]; const float* SS = (const float*)(ws + WS_SS3);
        f32x4 gv[4];
#pragma unroll
        for (int j = 0; j < 4; ++j) gv[j] = *(const f32x4*)(gf + 256 * j + 4 * lane);
        for (int row = blockIdx.x * 8 + wave; row < MROWS; row += G * 8) {
            const f32x4* sp = (const f32x4*)(SS + (size_t)row * 16);
            const f32x4 s0 = sp[0], s1 = sp[1], s2 = sp[2], s3 = sp[3];
            const float ss = ((s0[0] + s0[1]) + (s0[2] + s0[3])) + ((s1[0] + s1[1]) + (s1[2] + s1[3])) + ((s2[0] + s2[1]) + (s2[2] + s2[3])) + ((s3[0] + s3[1]) + (s3[2] + s3[3]));
            const float rstd = __builtin_amdgcn_rsqf(ss * (1.0f / 1024.0f) + EPS);
            float* yr = p.out + (size_t)row * 1024;
#pragma unroll
            for (int j = 0; j < 4; ++j) { f32x4* q = (f32x4*)(yr + 256 * j + 4 * lane); *q = *q * rstd * gv[j]; }
        }
    }
}

#ifndef N_LAUNCH_MODE
#define N_LAUNCH_MODE 1
#endif
extern "C" void kernel_launch(void* const* d_in, const int* in_sizes, int n_in, void* d_out, int out_size, void* d_ws, size_t ws_size, hipStream_t stream) {
    static int grid = 0;
    if (!grid) {
        if (n_in != 23 || ws_size < WS_END) { fprintf(stderr, "kernel_launch: unexpected n_in %d / ws_size %zu\n", n_in, ws_size); return; }
        int dev = 0, cus = 0, per_cu = 0;
        hipGetDevice(&dev); hipDeviceGetAttribute(&cus, hipDeviceAttributeMultiprocessorCount, dev);
        hipFuncSetAttribute((const void*)fwd, hipFuncAttributeMaxDynamicSharedMemorySize, LDS_BYTES);
        hipOccupancyMaxActiveBlocksPerMultiprocessor(&per_cu, fwd, 512, LDS_BYTES);
        if (per_cu < 1) { fprintf(stderr, "kernel_launch: occupancy query says %d blocks per CU\n", per_cu); per_cu = 1; }
        grid = cus;
    }
    Params p{};
    for (int i = 0; i < 23; ++i) p.in[i] = (const float*)d_in[i];
    p.out = (float*)d_out; p.ws = (unsigned char*)d_ws;
    if (N_LAUNCH_MODE == 1) {
        p.ph_lo = 0; p.ph_hi = 8;
        void* args[] = {&p};
        hipError_t e = hipLaunchCooperativeKernel((const void*)fwd, dim3(grid), dim3(512), args, LDS_BYTES, stream);
        if (e != hipSuccess) fprintf(stderr, "cooperative launch failed: %s (grid %d)\n", hipGetErrorString(e), grid);
    } else {
        for (int ph = 0; ph < 8; ++ph) { p.ph_lo = ph; p.ph_hi = ph + 1; hipLaunchKernelGGL(fwd, dim3(grid), dim3(512), LDS_BYTES, stream, p); }
    }
}
```

```cpp
#include <hip/hip_runtime.h>
#include <hip/hip_cooperative_groups.h>
#include <cstdio>
#include <cstdint>
namespace cg = cooperative_groups;
namespace pg8 {
#define PG8_LAS __attribute__((address_space(3)))
typedef unsigned short bf16_t;
typedef short bf16x8 __attribute__((ext_vector_type(8)));
typedef float f32x4 __attribute__((ext_vector_type(4)));
typedef unsigned u32x4 __attribute__((ext_vector_type(4)));
constexpr int BM = 256, BK = 64, HALF = 128, HTB = HALF * BK * 2  , STAGE_BYTES = 8 * HTB, NXCD = 8, WGM = 8;

__host__ __device__ __forceinline__ int lds_byte(int r, int c) { const int st = (r >> 4) * 2 + (c >> 5), rr = r & 15, cc = c & 31, ob = rr * 64 + cc * 2; return st * 1024 + (ob ^ (((ob >> 9) & 1) << 5)); }
__host__ __device__ __forceinline__ void stage_rc(int b, int& R, int& C) { const int st = b / 1024, sb = b % 1024, swz = sb ^ (((sb >> 9) & 1) << 5); R = (st >> 1) * 16 + swz / 64; C = (st & 1) * 32 + (swz % 64) / 2; }
__host__ __device__ __forceinline__ int perm32(int rho) { const int n = rho >> 4, i = rho & 15; return 8 * (i >> 2) + 4 * n + (i & 3); }

struct Unit { int pm, pn; };
struct Gemm { const bf16_t* A; const bf16_t* Bt; int M, N, K; };

struct StaticOrder {
    int nM, nN, nwg, G, c;
    __host__ __device__ void init(int M, int N, int G_, int c_) { nM = M / BM; nN = N / BM; nwg = nM * nN; G = G_; c = c_; }
    __host__ __device__ bool next(int i, Unit& u) const {
        const long L = (long)i * G + c; if (L >= nwg) return false;
        int wgid = (int)L; { const int q = nwg / NXCD, r = nwg % NXCD, xcd = wgid % NXCD, off = wgid / NXCD; wgid = (xcd < r ? xcd * (q + 1) : r * (q + 1) + (xcd - r) * q) + off; }
        const int nig = WGM * nN, gid = wgid / nig, fm = gid * WGM, gsz = (nM - fm) < WGM ? (nM - fm) : WGM;
        u.pm = fm + ((wgid % nig) % gsz); u.pn = (wgid % nig) / gsz; return true;
    }
    __device__ __forceinline__ void a_ready(const Unit&) const {}
    __device__ __forceinline__ void done(const Unit&) const {}
};
__device__ __forceinline__ unsigned cvt_pk_bf16(float lo, float hi) { unsigned r; asm volatile("v_cvt_pk_bf16_f32 %0, %1, %2" : "=v"(r) : "v"(lo), "v"(hi)); return r; }
template <class Epi, class Sched, bool ALIGN_EPI = false, bool SP2 = false>
__device__ __forceinline__ void gemm_phase(PG8_LAS unsigned char* lds, const Gemm g, const Sched& S, const Epi& E) {
    const int tid = threadIdx.x, wid = __builtin_amdgcn_readfirstlane(tid >> 6), lane = tid & 63, wr = wid >> 2, wc = wid & 3, fr = lane & 15, fq = lane >> 4;
    const int K = g.K, nt = K / BK;
    unsigned voffA[2], voffB[2];
#pragma unroll
    for (int i = 0; i < 2; ++i) { int R, C; stage_rc(tid * 16 + i * 8192, R, C); const int Rb = Epi::PERM ? ((R & ~31) + perm32(R & 31)) : R;
        voffA[i] = (unsigned)(R * K + C) * 2u; voffB[i] = (unsigned)(Rb * K + C) * 2u; }
    const size_t kstep = (size_t)(BK * 2);
    const size_t hstep = (size_t)HALF * K * 2;
    const size_t tstep = 2 * hstep;
    const unsigned ldsw = (unsigned)wid * 1024u;
    const int aoff = lds_byte(wr * 64 + fr, fq * 8), boff = lds_byte(wc * 32 + fr, fq * 8);
#define PG8_SA(b, h) (((b) * 2 + (h)) * HTB)
#define PG8_SB(b, h) ((4 + (b) * 2 + (h)) * HTB)
#define PG8_STAGE(bufoff, gbase, voff) do { _Pragma("unroll") for (int _i = 0; _i < 2; ++_i) \
        __builtin_amdgcn_global_load_lds((const unsigned*)((const char*)(gbase) + (voff)[_i]), (PG8_LAS unsigned*)(lds + (bufoff) + ldsw + _i * 8192), 16, 0, 0); } while (0)
#define PG8_LDA(dst, b, h) do { _Pragma("unroll") for (int m = 0; m < 4; ++m) _Pragma("unroll") for (int k = 0; k < 2; ++k) dst[m][k] = *(const PG8_LAS bf16x8*)(lds + PG8_SA(b, h) + aoff + m * 2048 + k * 1024); } while (0)
#define PG8_LDB(dst, b, h) do { _Pragma("unroll") for (int n = 0; n < 2; ++n) _Pragma("unroll") for (int k = 0; k < 2; ++k) dst[n][k] = *(const PG8_LAS bf16x8*)(lds + PG8_SB(b, h) + boff + n * 2048 + k * 1024); } while (0)
#define PG8_MMA(ai, bj, At, Bt) do { __builtin_amdgcn_s_setprio(1); _Pragma("unroll") for (int m = 0; m < 4; ++m) _Pragma("unroll") for (int n = 0; n < 2; ++n) _Pragma("unroll") for (int k = 0; k < 2; ++k) \
        acc[ai][bj][m][n] = __builtin_amdgcn_mfma_f32_16x16x32_bf16(Bt[n][k], At[m][k], acc[ai][bj][m][n], 0, 0, 0); __builtin_amdgcn_s_setprio(0); } while (0)
#define PG8_WAIT_V(n) asm volatile("s_waitcnt vmcnt(" #n ")" ::: "memory")
#define PG8_WAIT_L(n) asm volatile("s_waitcnt lgkmcnt(" #n ")" ::: "memory")
#define PG8_BAR __builtin_amdgcn_s_barrier()
#define PG8_SCHED __builtin_amdgcn_sched_barrier(0)
    Unit cur, nxt; int ui = 0;
    if (!S.next(0, cur)) return;
    f32x4 acc[2][2][4][2];
#pragma unroll
    for (int a = 0; a < 2; ++a)
#pragma unroll
        for (int b = 0; b < 2; ++b)
#pragma unroll
            for (int m = 0; m < 4; ++m)
#pragma unroll
                for (int n = 0; n < 2; ++n) acc[a][b][m][n] = (f32x4){0.f, 0.f, 0.f, 0.f};
    bf16x8 At[4][2], B0[2][2], B1[2][2];
    const char* cA = (const char*)g.A + (size_t)cur.pm * tstep; const char* cB = (const char*)g.Bt + (size_t)cur.pn * tstep;
    S.a_ready(cur);
    if constexpr (SP2) {
        PG8_STAGE(PG8_SB(0, 0), cB, voffB); PG8_STAGE(PG8_SB(0, 1), cB + hstep, voffB); PG8_STAGE(PG8_SA(0, 0), cA, voffA); PG8_STAGE(PG8_SA(0, 1), cA + hstep, voffA);
        if (wr == 1) PG8_BAR;
        PG8_WAIT_V(2); PG8_BAR;
        PG8_STAGE(PG8_SB(1, 0), cB + kstep, voffB); PG8_STAGE(PG8_SA(1, 0), cA + kstep, voffA); PG8_STAGE(PG8_SB(1, 1), cB + hstep + kstep, voffB);
        PG8_WAIT_V(6); PG8_BAR;
    } else {
        PG8_STAGE(PG8_SB(0, 0), cB, voffB); PG8_STAGE(PG8_SA(0, 0), cA, voffA); PG8_STAGE(PG8_SB(0, 1), cB + hstep, voffB); PG8_STAGE(PG8_SA(0, 1), cA + hstep, voffA);
        if (wr == 1) PG8_BAR;
        PG8_WAIT_V(4); PG8_BAR;
        PG8_STAGE(PG8_SB(1, 0), cB + kstep, voffB); PG8_STAGE(PG8_SA(1, 0), cA + kstep, voffA); PG8_STAGE(PG8_SB(1, 1), cB + hstep + kstep, voffB);
        PG8_WAIT_V(6); PG8_BAR;
    }
    for (;;) {
        const bool has_next = S.next(ui + 1, nxt);
        const char* nA = has_next ? (const char*)g.A + (size_t)nxt.pm * tstep : cA; const char* nB = has_next ? (const char*)g.Bt + (size_t)nxt.pn * tstep : cB;
        for (int t = 0; t < nt; t += 2) {
            const bool last = (t == nt - 2);
            const char* a1 = cA + (size_t)(t + 1) * kstep;
            const char* a2 = last ? nA : cA + (size_t)(t + 2) * kstep; const char* b2 = last ? nB : cB + (size_t)(t + 2) * kstep;
            const char* a3 = a2 + kstep; const char* b3 = b2 + kstep;
            if (last && has_next) S.a_ready(nxt);
            if constexpr (SP2) {
            PG8_LDB(B0, 0, 0); PG8_LDB(B1, 0, 1); PG8_SCHED; PG8_LDA(At, 0, 0); PG8_STAGE(PG8_SA(1, 1), a1 + hstep, voffA);
            PG8_WAIT_V(8); PG8_WAIT_L(0); PG8_BAR; PG8_MMA(0, 0, At, B0); PG8_MMA(0, 1, At, B1); PG8_BAR; PG8_SCHED;
            PG8_LDA(At, 0, 1); PG8_STAGE(PG8_SB(0, 0), b2, voffB); PG8_STAGE(PG8_SB(0, 1), b2 + hstep, voffB); PG8_STAGE(PG8_SA(0, 0), a2, voffA);
            PG8_WAIT_V(8); PG8_WAIT_L(0); PG8_BAR; PG8_MMA(1, 0, At, B0); PG8_MMA(1, 1, At, B1); PG8_BAR; PG8_SCHED;
            PG8_LDB(B0, 1, 0); PG8_LDB(B1, 1, 1); PG8_SCHED; PG8_LDA(At, 1, 0); PG8_STAGE(PG8_SA(0, 1), a2 + hstep, voffA);
            PG8_WAIT_V(8); PG8_WAIT_L(0); PG8_BAR; PG8_MMA(0, 0, At, B0); PG8_MMA(0, 1, At, B1); PG8_BAR; PG8_SCHED;
            PG8_LDA(At, 1, 1); PG8_STAGE(PG8_SB(1, 0), b3, voffB); PG8_STAGE(PG8_SB(1, 1), b3 + hstep, voffB); PG8_STAGE(PG8_SA(1, 0), a3, voffA);
            PG8_WAIT_V(8); PG8_WAIT_L(0); PG8_BAR; PG8_MMA(1, 0, At, B0); PG8_MMA(1, 1, At, B1); PG8_BAR; PG8_SCHED;
            } else {
            PG8_LDB(B0, 0, 0); PG8_SCHED; PG8_LDA(At, 0, 0); PG8_STAGE(PG8_SA(1, 1), a1 + hstep, voffA);
            PG8_WAIT_L(8); PG8_BAR; PG8_WAIT_L(0); PG8_MMA(0, 0, At, B0); PG8_BAR; PG8_SCHED;
            PG8_LDB(B1, 0, 1); PG8_STAGE(PG8_SB(0, 0), b2, voffB);
            PG8_BAR; PG8_WAIT_L(0); PG8_MMA(0, 1, At, B1); PG8_BAR;
            PG8_LDA(At, 0, 1); PG8_STAGE(PG8_SA(0, 0), a2, voffA);
            PG8_BAR; PG8_WAIT_L(0); PG8_MMA(1, 0, At, B0); PG8_BAR; PG8_SCHED;
            PG8_STAGE(PG8_SB(0, 1), b2 + hstep, voffB);
            PG8_WAIT_V(6); PG8_BAR; PG8_MMA(1, 1, At, B1); PG8_BAR;
            PG8_LDB(B0, 1, 0); PG8_SCHED; PG8_LDA(At, 1, 0); PG8_STAGE(PG8_SA(0, 1), a2 + hstep, voffA);
            PG8_WAIT_L(8); PG8_BAR; PG8_WAIT_L(0); PG8_MMA(0, 0, At, B0); PG8_BAR; PG8_SCHED;
            PG8_LDB(B1, 1, 1); PG8_STAGE(PG8_SB(1, 0), b3, voffB);
            PG8_BAR; PG8_WAIT_L(0); PG8_MMA(0, 1, At, B1); PG8_BAR;
            PG8_LDA(At, 1, 1); PG8_STAGE(PG8_SA(1, 0), a3, voffA);
            PG8_BAR; PG8_WAIT_L(0); PG8_MMA(1, 0, At, B0); PG8_BAR; PG8_SCHED;
            PG8_STAGE(PG8_SB(1, 1), b3 + hstep, voffB);
            PG8_WAIT_V(6); PG8_BAR; PG8_MMA(1, 1, At, B1); PG8_BAR;
            }
        }
        if constexpr (ALIGN_EPI) { if (wr == 0) PG8_BAR; }
        if constexpr (!Epi::AFTER_DRAIN) { E(acc, cur, wr, wc, fr, fq); S.done(cur); }
        if (!has_next) break;
#pragma unroll
        for (int a = 0; a < 2; ++a)
#pragma unroll
            for (int b = 0; b < 2; ++b)
#pragma unroll
                for (int m = 0; m < 4; ++m)
#pragma unroll
                    for (int n = 0; n < 2; ++n) acc[a][b][m][n] = (f32x4){0.f, 0.f, 0.f, 0.f};
        cur = nxt; cA = nA; cB = nB; ++ui;
        if constexpr (ALIGN_EPI) { if (wr == 1) PG8_BAR; }
    }
    PG8_WAIT_V(0);
    if constexpr (!ALIGN_EPI) { if (wr == 0) PG8_BAR; }
    PG8_BAR;
    if constexpr (Epi::AFTER_DRAIN) { E.fused(acc, cur, wr, wc, fr, fq, lds, wid, lane); S.done(cur); }
#undef PG8_SA
#undef PG8_SB
#undef PG8_STAGE
#undef PG8_LDA
#undef PG8_LDB
#undef PG8_MMA
#undef PG8_WAIT_V
#undef PG8_WAIT_L
#undef PG8_BAR
#undef PG8_SCHED
}
}

#define LAS __attribute__((address_space(3)))
typedef unsigned short bf16;
typedef short bf16x8 __attribute__((ext_vector_type(8)));
typedef short s16x4 __attribute__((ext_vector_type(4)));
typedef float f32x4 __attribute__((ext_vector_type(4)));
typedef float f32x16 __attribute__((ext_vector_type(16)));
typedef unsigned u32x4 __attribute__((ext_vector_type(4)));
typedef unsigned u32x2 __attribute__((ext_vector_type(2)));

constexpr int D_MODEL = 1024, NPROMPT = 32768, NSAMPLE = 512, MROWS = NPROMPT + NSAMPLE;
constexpr int SEQ = 8192, IN_W = 1792, D_FF = 2816;
constexpr float EPS = 1e-6f, LOG2E = 1.4426950408889634f, QSCALE = 0.125f * LOG2E;
constexpr size_t O_YP = 0, O_YS = 33554432, O_KP = 34078720, O_VP = 34144256, O_CP = 34209792, O_HP = 34215936, O_KS = 34217984, O_VS = 36315136, O_CS = 38412288, O_HS = 38608896;
constexpr size_t MiB = 1u << 20;
constexpr size_t WS_WIN = 1 * MiB, WS_WOUT = 5 * MiB, WS_WFI = 7 * MiB, WS_WFO = 18 * MiB, WS_WA = 24 * MiB, WS_WI = 24 * MiB + 65536;
constexpr size_t WS_SUMA = 25 * MiB, WS_SUMB = 26 * MiB, WS_SS2 = 27 * MiB, WS_SS3 = 30 * MiB, WS_HB = 33 * MiB;
constexpr size_t WS_XN = 98 * MiB, WS_Q = 163 * MiB, WS_K = 196 * MiB, WS_V = 205 * MiB, WS_XB = 214 * MiB, WS_GY = 247 * MiB, WS_MIX = 280 * MiB, WS_ACT = 98 * MiB, WS_END = 345 * MiB;
constexpr int LDS_BYTES = 147456;

struct Params { const float* in[23]; float* out; unsigned char* ws; int ph_lo, ph_hi; };

__device__ __forceinline__ unsigned pk2(float lo, float hi) {
    typedef __bf16 bf2 __attribute__((ext_vector_type(2)));
    bf2 v; v.x = (__bf16)lo; v.y = (__bf16)hi; return __builtin_bit_cast(unsigned, v);
}
__device__ __forceinline__ unsigned short f2bf(float f) { return (unsigned short)(pk2(f, 0.f) & 0xffffu); }
__device__ __forceinline__ float bf2f(unsigned short b) { return __uint_as_float((unsigned)b << 16); }
__device__ __forceinline__ void store8(bf16* dst, f32x4 a, f32x4 b) {
    u32x4 w; w.x = pk2(a[0], a[1]); w.y = pk2(a[2], a[3]); w.z = pk2(b[0], b[1]); w.w = pk2(b[2], b[3]); *(u32x4*)dst = w;
}
__device__ __forceinline__ float fast_sigmoid(float x) { return __builtin_amdgcn_rcpf(1.0f + __expf(-x)); }
__device__ __forceinline__ float gelu_tanh(float x) { const float u = 0.7978845608028654f * (x + 0.044715f * x * x * x); return x * __builtin_amdgcn_rcpf(1.0f + __expf(-2.0f * u)); }
__device__ __forceinline__ float wave_sum(float v) {
#pragma unroll
    for (int o = 1; o < 64; o <<= 1) v += __shfl_xor(v, o);
    return v;
}
__device__ __forceinline__ float wave_max(float v) {
#pragma unroll
    for (int o = 1; o < 64; o <<= 1) v = fmaxf(v, __shfl_xor(v, o));
    return v;
}

using pg8::Unit;
struct Epi1 {
    static constexpr bool PERM = true, AFTER_DRAIN = false;
    const float* bias; bf16 *Q, *Kb, *Vb, *XB, *GY; float* out;
    __device__ __forceinline__ void operator()(const f32x4 (&acc)[2][2][4][2], const Unit& u, int wr, int wc, int fr, int fq) const {
        const int pn = u.pn;
#pragma unroll
        for (int bj = 0; bj < 2; ++bj) {
            const int gcol = pn * 256 + bj * 128 + wc * 32 + fq * 8;
            const f32x4 b0 = *(const f32x4*)(bias + gcol), b1 = *(const f32x4*)(bias + gcol + 4);
#pragma unroll
            for (int ai = 0; ai < 2; ++ai)
#pragma unroll
                for (int m = 0; m < 4; ++m) {
                    const int row = u.pm * 256 + ai * 128 + wr * 64 + m * 16 + fr;
                    f32x4 v0 = acc[ai][bj][m][0] + b0, v1 = acc[ai][bj][m][1] + b1;
                    if (pn < 2) {
                        store8(Q + (size_t)row * 512 + gcol, v0 * QSCALE, v1 * QSCALE);
                    } else if (pn == 2) {
                        const int c = wc * 32 + fq * 8;
                        store8((bj == 0 ? Kb : Vb) + (size_t)row * 128 + c, v0, v1);
                        float* o = nullptr;
                        if (row < NPROMPT) { const int t = row & 8191; if (t >= 8064) o = out + (bj == 0 ? O_KP : O_VP) + ((size_t)((row >> 13) * 128 + (t - 8064)) * 128 + c); }
                        else { const int r = row - NPROMPT; o = out + (bj == 0 ? O_KS : O_VS) + ((size_t)((r >> 2) * 128 + 124 + (r & 3)) * 128 + c); }
                        if (o) { *(f32x4*)o = v0; *(f32x4*)(o + 4) = v1; }
                    } else if (pn < 5) {
                        const int c = gcol - 768;
                        store8(XB + (size_t)row * 512 + c, v0, v1);
                        float* o = nullptr;
                        if (row < NPROMPT) { const int t = row & 8191; if (t >= 8189) o = out + O_CP + ((size_t)((row >> 13) * 3 + (t - 8189)) * 512 + c); }
                        else { const int r = row - NPROMPT, i = r & 3; if (i >= 1) o = out + O_CS + ((size_t)((r >> 2) * 3 + (i - 1)) * 512 + c); }
                        if (o) { *(f32x4*)o = v0; *(f32x4*)(o + 4) = v1; }
                    } else {
                        const int c = gcol - 1280;
#pragma unroll
                        for (int j = 0; j < 4; ++j) { v0[j] = gelu_tanh(v0[j]); v1[j] = gelu_tanh(v1[j]); }
                        store8(GY + (size_t)row * 512 + c, v0, v1);
                    }
                }
        }
    }
};
struct Epi2 {
    static constexpr bool PERM = false, AFTER_DRAIN = false;
    const float *xp, *xs, *bias; float* out; bf16* Hb; float* SS;
    __device__ __forceinline__ void operator()(const f32x4 (&acc)[2][2][4][2], const Unit& u, int wr, int wc, int fr, int fq) const {
        const int col0 = u.pn * 256 + wc * 32 + 4 * fq;
        f32x4 bv[2][2];
#pragma unroll
        for (int bj = 0; bj < 2; ++bj)
#pragma unroll
            for (int n = 0; n < 2; ++n) bv[bj][n] = *(const f32x4*)(bias + col0 + bj * 128 + n * 16);
#pragma unroll
        for (int ai = 0; ai < 2; ++ai)
#pragma unroll
            for (int m = 0; m < 4; ++m) {
                const int row = u.pm * 256 + ai * 128 + wr * 64 + m * 16 + fr;
                const float* xrow = row < NPROMPT ? xp + (size_t)row * 1024 : xs + (size_t)(row - NPROMPT) * 1024;
                float s = 0.f;
#pragma unroll
                for (int bj = 0; bj < 2; ++bj)
#pragma unroll
                    for (int n = 0; n < 2; ++n) {
                        const int c = col0 + bj * 128 + n * 16;
                        const f32x4 hv = acc[ai][bj][m][n] + bv[bj][n] + *(const f32x4*)(xrow + c);
                        u32x2 w; w.x = pk2(hv[0], hv[1]); w.y = pk2(hv[2], hv[3]); *(u32x2*)(Hb + (size_t)row * 1024 + c) = w;
                        s += (hv[0] * hv[0] + hv[1] * hv[1]) + (hv[2] * hv[2] + hv[3] * hv[3]);
                    }
                s += __shfl_xor(s, 16); s += __shfl_xor(s, 32);
                if (fq == 0) SS[(size_t)row * 16 + u.pn * 4 + wc] = s;
            }
    }
};
struct Epi3 {
    static constexpr bool PERM = true, AFTER_DRAIN = false;
    const float* SS; bf16* ACT;
    __device__ __forceinline__ void operator()(const f32x4 (&acc)[2][2][4][2], const Unit& u, int wr, int wc, int fr, int fq) const {
        const int j0 = u.pn * 128 + wc * 32 + fq * 8;
#pragma unroll
        for (int ai = 0; ai < 2; ++ai)
#pragma unroll
            for (int m = 0; m < 4; ++m) {
                const int row = u.pm * 256 + ai * 128 + wr * 64 + m * 16 + fr;
                const f32x4* sp = (const f32x4*)(SS + (size_t)row * 16);
                const f32x4 s0 = sp[0], s1 = sp[1], s2 = sp[2], s3 = sp[3];
                const float ss = ((s0[0] + s0[1]) + (s0[2] + s0[3])) + ((s1[0] + s1[1]) + (s1[2] + s1[3])) + ((s2[0] + s2[1]) + (s2[2] + s2[3])) + ((s3[0] + s3[1]) + (s3[2] + s3[3]));
                const float rstd = __builtin_amdgcn_rsqf(ss * (1.0f / 1024.0f) + EPS);
                f32x4 a[2];
#pragma unroll
                for (int n = 0; n < 2; ++n) {
                    const f32x4 g = acc[ai][0][m][n] * rstd, up = acc[ai][1][m][n] * rstd;
#pragma unroll
                    for (int j = 0; j < 4; ++j) a[n][j] = g[j] * fast_sigmoid(g[j]) * up[j];
                }
                store8(ACT + (size_t)row * D_FF + j0, a[0], a[1]);
            }
    }
};
struct Epi4 {
    static constexpr bool PERM = false, AFTER_DRAIN = false;
    float* out; const bf16* Hb; float* SS;
    __device__ __forceinline__ void operator()(const f32x4 (&acc)[2][2][4][2], const Unit& u, int wr, int wc, int fr, int fq) const {
        const int col0 = u.pn * 256 + wc * 32 + 4 * fq;
#pragma unroll
        for (int ai = 0; ai < 2; ++ai)
#pragma unroll
            for (int m = 0; m < 4; ++m) {
                const int row = u.pm * 256 + ai * 128 + wr * 64 + m * 16 + fr;
                float s = 0.f;
#pragma unroll
                for (int bj = 0; bj < 2; ++bj)
#pragma unroll
                    for (int n = 0; n < 2; ++n) {
                        const size_t off = (size_t)row * 1024 + col0 + bj * 128 + n * 16;
                        const u32x2 hw = *(const u32x2*)(Hb + off);
                        f32x4 y; y[0] = __uint_as_float(hw.x << 16); y[1] = __uint_as_float(hw.x & 0xffff0000u); y[2] = __uint_as_float(hw.y << 16); y[3] = __uint_as_float(hw.y & 0xffff0000u);
                        y += acc[ai][bj][m][n];
                        *(f32x4*)(out + off) = y;
                        s += (y[0] * y[0] + y[1] * y[1]) + (y[2] * y[2] + y[3] * y[3]);
                    }
                s += __shfl_xor(s, 16); s += __shfl_xor(s, 32);
                if (fq == 0) SS[(size_t)row * 16 + u.pn * 4 + wc] = s;
            }
    }
};

#ifndef DUP_PH
#define DUP_PH -1
#endif
template <bool DUP> struct ProbeOrder : pg8::StaticOrder {
    __device__ bool next(int i, Unit& u) const {
        if (!DUP) return pg8::StaticOrder::next(i, u);
        const int R = c < nwg ? (nwg - c + G - 1) / G : 0;
        return i < 2 * R && pg8::StaticOrder::next(i < R ? i : i - R, u);
    }
};
__device__ __forceinline__ void transpose_item(const float* W, int K, int ldw, bf16* WT, int kb, int dst_n0, int src_n0, const float* g, LAS float* scr, int lane) {
    const int k0 = 64 * kb;
#pragma unroll 8
    for (int i = 0; i < 32; ++i) { const int kk = 2 * i + (lane >> 5); float v = W[(size_t)(k0 + kk) * ldw + src_n0 + (lane & 31)]; if (g) v *= g[k0 + kk]; scr[kk * 33 + (lane & 31)] = v; }
    asm volatile("s_waitcnt lgkmcnt(0)" ::: "memory");
    const int c = lane & 7;
#pragma unroll
    for (int j = 0; j < 4; ++j) { const int n = (lane >> 3) + 8 * j; const LAS float* s = scr + (8 * c) * 33 + n;
        u32x4 o; o.x = pk2(s[0 * 33], s[1 * 33]); o.y = pk2(s[2 * 33], s[3 * 33]); o.z = pk2(s[4 * 33], s[5 * 33]); o.w = pk2(s[6 * 33], s[7 * 33]);
        *(u32x4*)(WT + (size_t)(dst_n0 + n) * K + k0 + 8 * c) = o; }
    asm volatile("s_waitcnt lgkmcnt(0)" ::: "memory");
}
__device__ __forceinline__ void p0_prologue(const Params& p, LAS unsigned char* lds, int tid, int wave, int lane) {
    unsigned char* ws = p.ws;
    LAS float* scr = (LAS float*)(lds + wave * 16384);
    const int gw = blockIdx.x * 8 + wave, NGW = gridDim.x * 8;
    constexpr int I_IN = 16 * 56, I_OUT = 16 * 32, I_FI = 16 * 176, I_FO = 44 * 32, NITEMS = I_IN + I_OUT + I_FI + I_FO;
    for (int it = gw; it < NITEMS; it += NGW) {
        int r = it;
        if (r < I_IN) { const int kb = r / 56, nb = r % 56; transpose_item(p.in[7], 1024, IN_W, (bf16*)(ws + WS_WIN), kb, 32 * nb, 32 * nb, nullptr, scr, lane); continue; } r -= I_IN;
        if (r < I_OUT) { const int kb = r / 32, nb = r % 32; transpose_item(p.in[17], 1024, 1024, (bf16*)(ws + WS_WOUT), kb, 32 * nb, 32 * nb, nullptr, scr, lane); continue; } r -= I_OUT;
        if (r < I_FI) { const int kb = r / 176, nb = r % 176; const int d0 = 32 * nb, pn = d0 >> 8, bj = (d0 >> 7) & 1, i0 = d0 & 127;
            transpose_item(p.in[20], 1024, 2 * D_FF, (bf16*)(ws + WS_WFI), kb, d0, bj * D_FF + 128 * pn + i0, p.in[19], scr, lane); continue; } r -= I_FI;
        { const int kb = r / 32, nb = r % 32; transpose_item(p.in[21], D_FF, 1024, (bf16*)(ws + WS_WFO), kb, 32 * nb, 32 * nb, nullptr, scr, lane); }
    }
    const int gt = blockIdx.x * 512 + tid, NGT = gridDim.x * 512;
    for (int idx = gt; idx < 2 * 32768; idx += NGT) {
        const int which = idx >> 15, r = idx & 32767, n = r >> 12, e = (r >> 6) & 63, d = r & 63;
        const float v = (which ? p.in[14] : p.in[12])[n * 4096 + d * 64 + e];
        ((bf16*)(ws + (which ? WS_WI : WS_WA)))[r] = f2bf(v);
    }
    for (int idx = gt; idx < 2 * 128 * 3968; idx += NGT) {
        const int which = idx / (128 * 3968), r = idx % (128 * 3968), sb = r / 3968, e = r % 3968;
        const f32x4 v = *(const f32x4*)((which ? p.in[3] : p.in[2]) + (size_t)sb * 16384 + 512 + 4 * e);
        *(f32x4*)(p.out + (which ? O_VS : O_KS) + (size_t)sb * 16384 + 4 * e) = v;
    }
    const float* gm = p.in[6];
    f32x4 gv[4];
#pragma unroll
    for (int j = 0; j < 4; ++j) gv[j] = *(const f32x4*)(gm + 256 * j + 4 * lane);
    bf16* XN = (bf16*)(ws + WS_XN);
    for (int row = gw; row < MROWS; row += NGW) {
        const float* xr = row < NPROMPT ? p.in[0] + (size_t)row * 1024 : p.in[1] + (size_t)(row - NPROMPT) * 1024;
        f32x4 v[4]; float s = 0.f;
#pragma unroll
        for (int j = 0; j < 4; ++j) { v[j] = *(const f32x4*)(xr + 256 * j + 4 * lane); s += (v[j][0] * v[j][0] + v[j][1] * v[j][1]) + (v[j][2] * v[j][2] + v[j][3] * v[j][3]); }
        const float rstd = __builtin_amdgcn_rsqf(wave_sum(s) * (1.0f / 1024.0f) + EPS);
#pragma unroll
        for (int j = 0; j < 4; ++j) { const f32x4 o = v[j] * rstd * gv[j]; u32x2 w; w.x = pk2(o[0], o[1]); w.y = pk2(o[2], o[3]); *(u32x2*)(XN + (size_t)row * 1024 + 256 * j + 4 * lane) = w; }
    }
}

__device__ __forceinline__ void attn_prompt_unit(const Params& p, LAS unsigned char* lds, int unit, int tid, int wave, int lane) {
    const int kvh = unit & 1, nb = (unit >> 1) & 63, b = unit >> 7;
    const bf16* Qb = (const bf16*)(p.ws + WS_Q); const bf16* Kb = (const bf16*)(p.ws + WS_K); const bf16* Vb = (const bf16*)(p.ws + WS_V); bf16* MIX = (bf16*)(p.ws + WS_MIX);
    LAS unsigned char* Ks = lds; LAS unsigned char* Vs = lds + 36864;
    const int rowbase = b * SEQ + nb * 128;
#pragma unroll
    for (int i = 0; i < 4; ++i) {
        const int idx = tid + 512 * i, jr = idx >> 3, ck = idx & 7; const int grow = rowbase - 128 + jr;
        u32x4 kv = {0u, 0u, 0u, 0u}, vv = {0u, 0u, 0u, 0u};
        if (nb > 0 || jr >= 128) { kv = *(const u32x4*)(Kb + (size_t)grow * 128 + kvh * 64 + ck * 8); vv = *(const u32x4*)(Vb + (size_t)grow * 128 + kvh * 64 + ck * 8); }
        *(LAS u32x4*)(Ks + jr * 144 + ck * 16) = kv; *(LAS u32x4*)(Vs + jr * 192 + ck * 16) = vv;
    }
    __syncthreads();
    const int g = wave & 3, hh = kvh * 4 + g, c = lane & 31, h = lane >> 5;
    const float slope2 = exp2f(-(float)(hh + 1)) * LOG2E, sink2 = p.in[9][hh] * LOG2E;
#pragma unroll 1
    for (int ci = 0; ci < 2; ++ci) {
        const int r0 = 32 * ((wave >> 2) * 2 + ci);
        bf16x8 qf[4];
#pragma unroll
        for (int s = 0; s < 4; ++s) qf[s] = *(const bf16x8*)(Qb + (size_t)(rowbase + r0 + c) * 512 + hh * 64 + 16 * s + 8 * h);
        f32x16 S[5];
#pragma unroll
        for (int kt = 0; kt < 5; ++kt) {
#pragma unroll
            for (int r = 0; r < 16; ++r) S[kt][r] = 0.f;
#pragma unroll
            for (int s = 0; s < 4; ++s) { const bf16x8 kf = *(const LAS bf16x8*)(Ks + (r0 + 32 * kt + c) * 144 + (16 * s + 8 * h) * 2); S[kt] = __builtin_amdgcn_mfma_f32_32x32x16_bf16(kf, qf[s], S[kt], 0, 0, 0); }
        }
        float m = sink2;
        int base = 128 + c - 4 * h;
        asm volatile("" : "+v"(base));
        const float t0 = -slope2 * (float)base;
#pragma unroll
        for (int kt = 0; kt < 5; ++kt)
#pragma unroll
            for (int r = 0; r < 16; ++r) {
                const int K = 32 * kt + (r & 3) + 8 * (r >> 2);
                float sv = __builtin_fmaf(slope2, (float)K, S[kt][r] + t0);
                if (kt == 0) sv = (base - K < 128) ? sv : -1e30f;
                if (kt == 4) sv = (base - K >= 0) ? sv : -1e30f;
                S[kt][r] = sv;
            }
        if (nb == 0) {
#pragma unroll
            for (int kt = 0; kt < 5; ++kt)
#pragma unroll
                for (int r = 0; r < 16; ++r) { const int K = 32 * kt + (r & 3) + 8 * (r >> 2); if (r0 + 4 * h + K < 128) S[kt][r] = -1e30f; }
        }
#pragma unroll
        for (int kt = 0; kt < 5; ++kt)
#pragma unroll
            for (int r = 0; r < 16; ++r) m = fmaxf(m, S[kt][r]);
        m = fmaxf(m, __shfl_xor(m, 32));
        float l = 0.f;
#pragma unroll
        for (int kt = 0; kt < 5; ++kt)
#pragma unroll
            for (int r = 0; r < 16; ++r) { const float pv = __builtin_amdgcn_exp2f(S[kt][r] - m); S[kt][r] = pv; l += pv; }
        l += __shfl_xor(l, 32); l += __builtin_amdgcn_exp2f(sink2 - m);
        const float inv = 1.0f / l;
        f32x16 O0, O1;
#pragma unroll
        for (int r = 0; r < 16; ++r) { O0[r] = 0.f; O1[r] = 0.f; }
        const int vlane = ((lane & 15) >> 2) * 192 + (16 * ((lane >> 4) & 1) + 4 * (lane & 3)) * 2 + 4 * h * 192;
#pragma unroll
        for (int kt = 0; kt < 5; ++kt)
#pragma unroll
            for (int s = 0; s < 2; ++s) {
                u32x4 pw;
                pw.x = pk2(S[kt][8 * s + 0] * inv, S[kt][8 * s + 1] * inv); pw.y = pk2(S[kt][8 * s + 2] * inv, S[kt][8 * s + 3] * inv);
                pw.z = pk2(S[kt][8 * s + 4] * inv, S[kt][8 * s + 5] * inv); pw.w = pk2(S[kt][8 * s + 6] * inv, S[kt][8 * s + 7] * inv);
                const bf16x8 pa = __builtin_bit_cast(bf16x8, pw);
                const int kb = r0 + 32 * kt + 16 * s;
#pragma unroll
                for (int nt = 0; nt < 2; ++nt) {
                    const s16x4 v0 = __builtin_amdgcn_ds_read_tr16_b64_v4i16((LAS s16x4*)(Vs + kb * 192 + vlane + nt * 64));
                    const s16x4 v1 = __builtin_amdgcn_ds_read_tr16_b64_v4i16((LAS s16x4*)(Vs + (kb + 8) * 192 + vlane + nt * 64));
                    bf16x8 vb; vb[0] = v0[0]; vb[1] = v0[1]; vb[2] = v0[2]; vb[3] = v0[3]; vb[4] = v1[0]; vb[5] = v1[1]; vb[6] = v1[2]; vb[7] = v1[3];
                    if (nt == 0) O0 = __builtin_amdgcn_mfma_f32_32x32x16_bf16(pa, vb, O0, 0, 0, 0); else O1 = __builtin_amdgcn_mfma_f32_32x32x16_bf16(pa, vb, O1, 0, 0, 0);
                }
                asm volatile("" ::: "memory");
            }
#pragma unroll
        for (int r = 0; r < 16; ++r) {
            const int qrow = r0 + (r & 3) + 8 * (r >> 2) + 4 * h;
            bf16* o = MIX + (size_t)(rowbase + qrow) * 1024 + hh * 64 + c;
            o[0] = f2bf(O0[r]); o[32] = f2bf(O1[r]);
        }
    }
    __syncthreads();
}

__device__ __forceinline__ void attn_sample_unit(const Params& p, LAS unsigned char* lds, int unit, int tid, int wave, int lane) {
    const int kvh = unit & 1, sb = unit >> 1;
    const bf16* Qb = (const bf16*)(p.ws + WS_Q); bf16* MIX = (bf16*)(p.ws + WS_MIX);
    LAS float* Kf = (LAS float*)lds; LAS float* Vf = Kf + 132 * 65; LAS float* Qf = Vf + 132 * 64; LAS float* Pf = Qf + 1024;
    for (int i = 0; i < 17; ++i) {
        const int idx = tid + 512 * i;
        if (idx < 132 * 64) {
            const int j = idx >> 6, d = idx & 63; float kv, vv;
            if (j < 4) { const size_t o = ((size_t)(sb * 128 + j) * 2 + kvh) * 64 + d; kv = p.in[2][o]; vv = p.in[3][o]; }
            else { const size_t o = (size_t)(sb * 128 + j - 4) * 128 + kvh * 64 + d; kv = p.out[O_KS + o]; vv = p.out[O_VS + o]; }
            Kf[j * 65 + d] = kv; Vf[j * 64 + d] = vv;
        }
    }
#pragma unroll
    for (int i = 0; i < 2; ++i) { const int idx = tid + 512 * i, rr = idx >> 6, d = idx & 63;
        Qf[idx] = bf2f(Qb[(size_t)(NPROMPT + sb * 4 + (rr & 3)) * 512 + (kvh * 4 + (rr >> 2)) * 64 + d]); }
    __syncthreads();
#pragma unroll 1
    for (int r2 = 0; r2 < 2; ++r2) {
        const int rr = wave * 2 + r2, g = rr >> 2, it = rr & 3, hh = kvh * 4 + g;
        const float slope2 = exp2f(-(float)(hh + 1)) * LOG2E, sink2 = p.in[9][hh] * LOG2E;
        float sc[3]; float m = sink2;
#pragma unroll
        for (int kk = 0; kk < 3; ++kk) {
            const int j = lane + 64 * kk, jj = j < 132 ? j : 131; float s = 0.f;
#pragma unroll 8
            for (int d = 0; d < 64; ++d) s += Qf[rr * 64 + d] * Kf[jj * 65 + d];
            const int dist = 128 + it - j; const bool valid = (j < 132) && (dist >= 0) && (dist < 128);
            sc[kk] = valid ? s - slope2 * (float)dist : -1e30f; m = fmaxf(m, sc[kk]);
        }
        m = wave_max(m);
        float l = 0.f;
#pragma unroll
        for (int kk = 0; kk < 3; ++kk) { sc[kk] = __builtin_amdgcn_exp2f(sc[kk] - m); l += sc[kk]; }
        l = wave_sum(l) + __builtin_amdgcn_exp2f(sink2 - m);
        const float inv = 1.0f / l;
#pragma unroll
        for (int kk = 0; kk < 3; ++kk) { const int j = lane + 64 * kk; if (j < 132) Pf[wave * 136 + j] = sc[kk] * inv; }
        __syncthreads();
        float o = 0.f;
#pragma unroll 4
        for (int j = 0; j < 132; ++j) o += Pf[wave * 136 + j] * Vf[j * 64 + lane];
        MIX[(size_t)(NPROMPT + sb * 4 + it) * 1024 + hh * 64 + lane] = f2bf(o);
        __syncthreads();
    }
}

template <int MODE>
__device__ __forceinline__ void lru_unit(const Params& p, LAS unsigned char* lds, int unit, int wave, int lane) {
    const int n = wave, cp = lane & 31, th = lane >> 5, c = lane & 31, h = lane >> 5;
    LAS unsigned char* xcs = lds + wave * 9216;
    const bf16* XB = (const bf16*)(p.ws + WS_XB); const bf16* GY = (const bf16*)(p.ws + WS_GY); bf16* MIX = (bf16*)(p.ws + WS_MIX);
    const bf16* WA = (const bf16*)(p.ws + WS_WA); const bf16* WI = (const bf16*)(p.ws + WS_WI);
    float* SUMA = (float*)(p.ws + WS_SUMA); float* SUMB = (float*)(p.ws + WS_SUMB);
    const int b = unit >> 7, chunk = unit & 127;
    const int rowbase = MODE < 2 ? b * SEQ + chunk * 64 : NPROMPT + unit * 32;
    {
        const int ch2 = n * 64 + 2 * cp;
        const float* cw = p.in[10]; const float* cb = p.in[11];
        const float w0a = cw[ch2], w0b = cw[ch2 + 1], w1a = cw[512 + ch2], w1b = cw[512 + ch2 + 1], w2a = cw[1024 + ch2], w2b = cw[1024 + ch2 + 1], w3a = cw[1536 + ch2], w3b = cw[1536 + ch2 + 1];
        const float bia = cb[ch2], bib = cb[ch2 + 1];
        if (MODE < 2) {
            const int tl0 = th * 32;
            float xa[3], xb[3];
#pragma unroll
            for (int i = 0; i < 3; ++i) {
                const int tl = tl0 - 3 + i; unsigned v = 0u;
                if (chunk > 0 || tl >= 0) v = *(const unsigned*)(XB + (size_t)(rowbase + tl) * 512 + ch2);
                xa[i] = bf2f((unsigned short)(v & 0xffffu)); xb[i] = bf2f((unsigned short)(v >> 16));
            }
#pragma unroll
            for (int t = 0; t < 32; ++t) {
                const unsigned v = *(const unsigned*)(XB + (size_t)(rowbase + tl0 + t) * 512 + ch2);
                const float x3a = bf2f((unsigned short)(v & 0xffffu)), x3b = bf2f((unsigned short)(v >> 16));
                const float ya = bia + w0a * xa[0] + w1a * xa[1] + w2a * xa[2] + w3a * x3a, yb = bib + w0b * xb[0] + w1b * xb[1] + w2b * xb[2] + w3b * x3b;
                *(LAS unsigned*)(xcs + (tl0 + t) * 144 + cp * 4) = pk2(ya, yb);
                xa[0] = xa[1]; xa[1] = xa[2]; xa[2] = x3a; xb[0] = xb[1]; xb[1] = xb[2]; xb[2] = x3b;
            }
        } else {
            const float* sc = p.in[4];
#pragma unroll
            for (int q = 0; q < 4; ++q) {
                const int bi = th * 4 + q, sb = unit * 8 + bi;
                float ia[7], ib[7];
#pragma unroll
                for (int i = 0; i < 3; ++i) { ia[i] = sc[(size_t)(sb * 3 + i) * 512 + ch2]; ib[i] = sc[(size_t)(sb * 3 + i) * 512 + ch2 + 1]; }
#pragma unroll
                for (int i = 0; i < 4; ++i) { const unsigned v = *(const unsigned*)(XB + (size_t)(rowbase + bi * 4 + i) * 512 + ch2); ia[3 + i] = bf2f((unsigned short)(v & 0xffffu)); ib[3 + i] = bf2f((unsigned short)(v >> 16)); }
#pragma unroll
                for (int i = 0; i < 4; ++i) {
                    const float ya = bia + w0a * ia[i] + w1a * ia[i + 1] + w2a * ia[i + 2] + w3a * ia[i + 3], yb = bib + w0b * ib[i] + w1b * ib[i + 1] + w2b * ib[i + 2] + w3b * ib[i + 3];
                    *(LAS unsigned*)(xcs + (bi * 4 + i) * 144 + cp * 4) = pk2(ya, yb);
                }
            }
        }
    }
    float hin = 0.f;
    if (MODE == 1) {
        const float* sa = SUMA + (size_t)(b * 128) * 512 + n * 64 + lane; const float* sbp = SUMB + (size_t)(b * 128) * 512 + n * 64 + lane;
        int j = 0;
        for (; j + 8 <= chunk; j += 8) {
            float aa[8], bb[8];
#pragma unroll
            for (int q = 0; q < 8; ++q) { aa[q] = sa[(size_t)(j + q) * 512]; bb[q] = sbp[(size_t)(j + q) * 512]; }
#pragma unroll
            for (int q = 0; q < 8; ++q) hin = aa[q] * hin + bb[q];
        }
        for (; j < chunk; ++j) hin = sa[(size_t)j * 512] * hin + sbp[(size_t)j * 512];
    }
    __syncthreads();
#pragma unroll 1
    for (int et = 0; et < 2; ++et) {
        const int chl = et * 32 + c, ch = n * 64 + chl;
        const float ba = p.in[13][ch], bi_ = p.in[15][ch], lam = p.in[16][ch];
        const float sp8 = 8.0f * log1pf(__expf(-lam));
        bf16x8 wa[4], wi[4];
#pragma unroll
        for (int s = 0; s < 4; ++s) { wa[s] = *(const bf16x8*)(WA + (size_t)(n * 64 + chl) * 64 + 16 * s + 8 * h); wi[s] = *(const bf16x8*)(WI + (size_t)(n * 64 + chl) * 64 + 16 * s + 8 * h); }
        float hcar = MODE == 1 ? __shfl(hin, chl) : 0.f;
        float Atot = 1.f;
#pragma unroll 1
        for (int tt = 0; tt < (MODE == 2 ? 1 : 2); ++tt) {
            f32x16 accA, accI;
#pragma unroll
            for (int r = 0; r < 16; ++r) { accA[r] = 0.f; accI[r] = 0.f; }
#pragma unroll
            for (int s = 0; s < 4; ++s) {
                const bf16x8 af = *(const LAS bf16x8*)(xcs + (tt * 32 + c) * 144 + (16 * s + 8 * h) * 2);
                accA = __builtin_amdgcn_mfma_f32_32x32x16_bf16(af, wa[s], accA, 0, 0, 0);
                accI = __builtin_amdgcn_mfma_f32_32x32x16_bf16(af, wi[s], accI, 0, 0, 0);
            }
            float av[16], bv[16];
#pragma unroll
            for (int r = 0; r < 16; ++r) {
                const int tok = tt * 32 + (r & 3) + 8 * (r >> 2) + 4 * h;
                const float xcv = bf2f(*(const LAS unsigned short*)(xcs + tok * 144 + chl * 2));
                const float rg = fast_sigmoid(accA[r] + ba), ig = fast_sigmoid(accI[r] + bi_);
                const float a = __expf(-sp8 * rg);
                av[r] = a; bv[r] = sqrtf(fmaxf(1.0f - a * a, 0.f)) * ig * xcv;
            }
            if (MODE < 2) {
                float Ae[4], Be[4], Ao[4], Bo[4];
#pragma unroll
                for (int g = 0; g < 4; ++g) {
                    const float A = (av[4 * g] * av[4 * g + 1]) * (av[4 * g + 2] * av[4 * g + 3]);
                    const float B = ((bv[4 * g] * av[4 * g + 1] + bv[4 * g + 1]) * av[4 * g + 2] + bv[4 * g + 2]) * av[4 * g + 3] + bv[4 * g + 3];
                    const float pA = __shfl_xor(A, 32), pB = __shfl_xor(B, 32);
                    Ae[g] = h ? pA : A; Be[g] = h ? pB : B; Ao[g] = h ? A : pA; Bo[g] = h ? B : pB;
                }
                float hs[4]; float x = hcar;
#pragma unroll
                for (int g = 0; g < 4; ++g) { const float he = x; x = Ae[g] * x + Be[g]; const float ho = x; x = Ao[g] * x + Bo[g]; hs[g] = h ? ho : he; Atot *= Ae[g] * Ao[g]; }
                hcar = x;
                if (MODE == 1) {
#pragma unroll
                    for (int g = 0; g < 4; ++g) {
                        float y = hs[g];
#pragma unroll
                        for (int i = 0; i < 4; ++i) {
                            y = av[4 * g + i] * y + bv[4 * g + i];
                            const int row = rowbase + tt * 32 + 8 * g + 4 * h + i;
                            const float gy = bf2f(GY[(size_t)row * 512 + ch]);
                            MIX[(size_t)row * 1024 + 512 + ch] = f2bf(y * gy);
                        }
                    }
                }
            } else {
#pragma unroll
                for (int g = 0; g < 4; ++g) {
                    const int sb = unit * 8 + 2 * g + h;
                    float y = p.in[5][(size_t)sb * 512 + ch];
#pragma unroll
                    for (int i = 0; i < 4; ++i) {
                        y = av[4 * g + i] * y + bv[4 * g + i];
                        const int row = rowbase + 8 * g + 4 * h + i;
                        const float gy = bf2f(GY[(size_t)row * 512 + ch]);
                        MIX[(size_t)row * 1024 + 512 + ch] = f2bf(y * gy);
                    }
                    p.out[O_HS + (size_t)sb * 512 + ch] = y;
                }
            }
        }
        if (MODE == 0 && h == 0) { SUMA[(size_t)(b * 128 + chunk) * 512 + ch] = Atot; SUMB[(size_t)(b * 128 + chunk) * 512 + ch] = hcar; }
        if (MODE == 1 && chunk == 127 && h == 0) p.out[O_HP + (size_t)b * 512 + ch] = hcar;
    }
    __syncthreads();
}

#define XB_TMO      128
#define XB_XCNT(j)  (256  + 64 * (j))
#define XB_XSUB(j)  (1280 + 64 * (j))
#define XB_XGEN(j)  (2304 + 64 * (j))
#define XB_TOP      3328
#define XB_TOPGEN   3392
#define XCD_BAR_WORDS 3456
#define XB_SPIN_CAP (1u << 18)

__device__ __forceinline__ unsigned xb_ld(unsigned* p)              { return __hip_atomic_load(p, __ATOMIC_RELAXED, __HIP_MEMORY_SCOPE_AGENT); }
__device__ __forceinline__ unsigned xb_add(unsigned* p, unsigned v) { return __hip_atomic_fetch_add(p, v, __ATOMIC_RELAXED, __HIP_MEMORY_SCOPE_AGENT); }
__device__ __forceinline__ unsigned xb_xcc_id() { return (unsigned)__builtin_amdgcn_s_getreg((3 << 11) | 20) & 0xFu; }
#define XB_SPIN(cond, bar) do { unsigned _sp = 0; while (cond) { __builtin_amdgcn_s_sleep(1); \
    if ((++_sp & 255u) == 0u) { if (xb_ld(&(bar)[XB_TMO])) break; if (_sp > XB_SPIN_CAP) { atomicAdd(&(bar)[XB_TMO], 1u); break; } } } } while (0)

struct XcdBarrier {
    unsigned* bar; unsigned x;
    volatile LAS unsigned* st;
};

__device__ __forceinline__ XcdBarrier xcd_barrier_post(unsigned* bar, volatile LAS unsigned* st) {
    XcdBarrier b; b.bar = bar; b.x = xb_xcc_id(); b.st = st;
    if (threadIdx.x == 0) (void)xb_add(&bar[XB_XCNT(b.x)], 1u);
    return b;
}
__device__ __forceinline__ void xcd_barrier_complete(unsigned* bar, unsigned x, unsigned& nloc, unsigned& nx) {
    const unsigned G = gridDim.x * gridDim.y * gridDim.z;
    unsigned sum, cnt, mine, sp = 0u;
    for (;;) {
        sum = 0u; cnt = 0u; mine = 0u;
#pragma unroll
        for (unsigned j = 0; j < 16; ++j) { const unsigned c = xb_ld(&bar[XB_XCNT(j)]); sum += c; cnt += (c > 0u) ? 1u : 0u; mine = (j == x) ? c : mine; }
        if (sum == G) break;
        __builtin_amdgcn_s_sleep(1);
        if ((++sp & 255u) == 0u) { if (xb_ld(&bar[XB_TMO])) break; if (sp > XB_SPIN_CAP) { atomicAdd(&bar[XB_TMO], 1u); break; } }
    }
    nloc = mine > 0u ? mine : 1u; nx = cnt > 0u ? cnt : 1u;
}

__device__ __forceinline__ void xcd_barrier(const XcdBarrier& b) {
    asm volatile("s_waitcnt vmcnt(0)" ::: "memory");
    __syncthreads();
    if (threadIdx.x == 0) {
        unsigned* bar = b.bar;
        __builtin_amdgcn_s_waitcnt(0);
        unsigned nloc = b.st[0], nx = b.st[1];
        if (nloc == 0u) { xcd_barrier_complete(bar, b.x, nloc, nx); b.st[0] = nloc; b.st[1] = nx; }
        const unsigned old = xb_add(&bar[XB_XSUB(b.x)], 1u);
        const unsigned gen = old / nloc;
        if (old + 1u == (gen + 1u) * nloc) {
            __builtin_amdgcn_fence(__ATOMIC_RELEASE, "agent");
            asm volatile("s_waitcnt vmcnt(0)" ::: "memory");
            const unsigned og = xb_add(&bar[XB_TOP], 1u);
            const unsigned tg = og / nx;
            if (og + 1u == (tg + 1u) * nx) xb_add(&bar[XB_TOPGEN], 1u);
            else XB_SPIN(xb_ld(&bar[XB_TOPGEN]) == tg, bar);
            __builtin_amdgcn_fence(__ATOMIC_ACQUIRE, "agent");
            xb_add(&bar[XB_XGEN(b.x)], 1u);
            asm volatile("s_waitcnt vmcnt(0)" ::: "memory");
        } else {
            XB_SPIN(xb_ld(&bar[XB_XGEN(b.x)]) == gen, bar);
            __builtin_amdgcn_fence(__ATOMIC_ACQUIRE, "agent");
            asm volatile("s_waitcnt vmcnt(0)" ::: "memory");
        }
    }
    __syncthreads();
}

__global__ void __launch_bounds__(512, 2) fwd(Params p) {
    extern __shared__ __attribute__((aligned(16))) unsigned char lds_raw[];
    LAS unsigned char* lds = (LAS unsigned char*)lds_raw;
    const int tid = threadIdx.x, lane = tid & 63, wave = __builtin_amdgcn_readfirstlane(tid >> 6);
    const int lo = p.ph_lo, hi = p.ph_hi, G = gridDim.x;
    unsigned char* ws = p.ws;
#ifdef ONLY_PH
#define IN_PH(k) ((k) == ONLY_PH)
#else
#define IN_PH(k) (lo <= (k) && (k) < hi)
#endif
#define REPS(k)
    volatile LAS unsigned* MISC = (volatile LAS unsigned*)(lds + 131072);
    if (tid < 64) MISC[tid] = 0u;
    __syncthreads();
    XcdBarrier bar; bar.bar = (unsigned*)ws; bar.x = 0; bar.st = nullptr;
    if (hi - lo > 1) bar = xcd_barrier_post((unsigned*)ws, MISC + 8);
#define SEAM(k) do { if (lo <= (k) && (k) + 1 < hi) { if ((k) == 0) cg::this_grid().sync(); else xcd_barrier(bar); if (DUP_PH == 99) xcd_barrier(bar); } } while (0)

    if (IN_PH(0)) { p0_prologue(p, lds, tid, wave, lane); if (DUP_PH == 0) p0_prologue(p, lds, tid, wave, lane); }
    SEAM(0);
    if (IN_PH(1)) REPS(1) {
        pg8::Gemm g{(const bf16*)(ws + WS_XN), (const bf16*)(ws + WS_WIN), MROWS, IN_W, 1024}; ProbeOrder<DUP_PH == 1> S; S.init(MROWS, IN_W, G, (int)blockIdx.x);
        Epi1 E{p.in[8], (bf16*)(ws + WS_Q), (bf16*)(ws + WS_K), (bf16*)(ws + WS_V), (bf16*)(ws + WS_XB), (bf16*)(ws + WS_GY), p.out};
        pg8::gemm_phase<Epi1, ProbeOrder<DUP_PH == 1>, true, true>(lds, g, S, E);
    }
    SEAM(1);
    if (IN_PH(2)) {
#pragma unroll 1
        for (int u = blockIdx.x; u < (DUP_PH == 20 ? 1024 : 512); u += G) attn_prompt_unit(p, lds, u & 511, tid, wave, lane);
#pragma unroll 1
        for (int u = blockIdx.x; u < (DUP_PH == 21 ? 1024 : 512); u += G) lru_unit<0>(p, lds, u & 511, wave, lane);
#pragma unroll 1
        for (int u = blockIdx.x; u < (DUP_PH == 22 ? 512 : 256); u += G) attn_sample_unit(p, lds, u & 255, tid, wave, lane);
    }
    SEAM(2);
    if (IN_PH(3)) REPS(3) {
#pragma unroll 1
        for (int u = blockIdx.x; u < (DUP_PH == 3 ? 1024 : 512); u += G) lru_unit<1>(p, lds, u & 511, wave, lane);
#pragma unroll 1
        for (int u = blockIdx.x; u < 16; u += G) lru_unit<2>(p, lds, u, wave, lane);
    }
    SEAM(3);
    if (IN_PH(4)) REPS(4) {
        pg8::Gemm g{(const bf16*)(ws + WS_MIX), (const bf16*)(ws + WS_WOUT), MROWS, 1024, 1024}; ProbeOrder<DUP_PH == 4> S; S.init(MROWS, 1024, G, (int)blockIdx.x);
        Epi2 E{p.in[0], p.in[1], p.in[18], p.out, (bf16*)(ws + WS_HB), (float*)(ws + WS_SS2)};
        pg8::gemm_phase<Epi2, ProbeOrder<DUP_PH == 4>, true, true>(lds, g, S, E);
    }
    SEAM(4);
    if (IN_PH(5)) REPS(5) {
        pg8::Gemm g{(const bf16*)(ws + WS_HB), (const bf16*)(ws + WS_WFI), MROWS, 2 * D_FF, 1024}; ProbeOrder<DUP_PH == 5> S; S.init(MROWS, 2 * D_FF, G, (int)blockIdx.x);
        Epi3 E{(const float*)(ws + WS_SS2), (bf16*)(ws + WS_ACT)};
        pg8::gemm_phase<Epi3, ProbeOrder<DUP_PH == 5>, true, true>(lds, g, S, E);
    }
    SEAM(5);
    if (IN_PH(6)) {
        pg8::Gemm g{(const bf16*)(ws + WS_ACT), (const bf16*)(ws + WS_WFO), MROWS, 1024, D_FF}; ProbeOrder<DUP_PH == 6> S; S.init(MROWS, 1024, G, (int)blockIdx.x);
        Epi4 E{p.out, (const bf16*)(ws + WS_HB), (float*)(ws + WS_SS3)};
        pg8::gemm_phase<Epi4, ProbeOrder<DUP_PH == 6>, true, true>(lds, g, S, E);
    }
    SEAM(6);
    if (IN_PH(7)) {
        const float* gf = p.in[22]; const float* SS = (const float*)(ws + WS_SS3);
        f32x4 gv[4];
#pragma unroll
        for (int j = 0; j < 4; ++j) gv[j] = *(const f32x4*)(gf + 256 * j + 4 * lane);
        for (int row = blockIdx.x * 8 + wave; row < MROWS; row += G * 8) {
            const f32x4* sp = (const f32x4*)(SS + (size_t)row * 16);
            const f32x4 s0 = sp[0], s1 = sp[1], s2 = sp[2], s3 = sp[3];
            const float ss = ((s0[0] + s0[1]) + (s0[2] + s0[3])) + ((s1[0] + s1[1]) + (s1[2] + s1[3])) + ((s2[0] + s2[1]) + (s2[2] + s2[3])) + ((s3[0] + s3[1]) + (s3[2] + s3[3]));
            const float rstd = __builtin_amdgcn_rsqf(ss * (1.0f / 1024.0f) + EPS);
            float* yr = p.out + (size_t)row * 1024;
#pragma unroll
            for (int j = 0; j < 4; ++j) { f32x4* q = (f32x4*)(yr + 256 * j + 4 * lane); *q = *q * rstd * gv[j]; }
        }
    }
}

#ifndef N_LAUNCH_MODE
#define N_LAUNCH_MODE 1
#endif
extern "C" void kernel_launch(void* const* d_in, const int* in_sizes, int n_in, void* d_out, int out_size, void* d_ws, size_t ws_size, hipStream_t stream) {
    static int grid = 0;
    if (!grid) {
        if (n_in != 23 || ws_size < WS_END) { fprintf(stderr, "kernel_launch: unexpected n_in %d / ws_size %zu\n", n_in, ws_size); return; }
        int dev = 0, cus = 0, per_cu = 0;
        hipGetDevice(&dev); hipDeviceGetAttribute(&cus, hipDeviceAttributeMultiprocessorCount, dev);
        hipFuncSetAttribute((const void*)fwd, hipFuncAttributeMaxDynamicSharedMemorySize, LDS_BYTES);
        hipOccupancyMaxActiveBlocksPerMultiprocessor(&per_cu, fwd, 512, LDS_BYTES);
        if (per_cu < 1) { fprintf(stderr, "kernel_launch: occupancy query says %d blocks per CU\n", per_cu); per_cu = 1; }
        grid = cus;
    }
    (void)hipMemsetAsync(d_ws, 0, 16384, stream);
    Params p{};
    for (int i = 0; i < 23; ++i) p.in[i] = (const float*)d_in[i];
    p.out = (float*)d_out; p.ws = (unsigned char*)d_ws;
    if (N_LAUNCH_MODE == 1) {
        p.ph_lo = 0; p.ph_hi = 8;
        void* args[] = {&p};
        hipError_t e = hipLaunchCooperativeKernel((const void*)fwd, dim3(grid), dim3(512), args, LDS_BYTES, stream);
        if (e != hipSuccess) fprintf(stderr, "cooperative launch failed: %s (grid %d)\n", hipGetErrorString(e), grid);
    } else {
        for (int ph = 0; ph < 8; ++ph) { p.ph_lo = ph; p.ph_hi = ph + 1; hipLaunchKernelGGL(fwd, dim3(grid), dim3(512), LDS_BYTES, stream, p); }
    }
}
```
